# Optimizing an MI355X kernel written in HIP

```python
import math
import jax, jax.numpy as jnp
from jax import lax
import numpy as np

D_MODEL = 1024
BATCH = 8
SEQ = 8192
DEPTH = 1

EPS = 1e-6
POOL_WINDOWS = (2, 4, 8, 16)
POOL_GROUPS = 4
POOL_WIDTH = D_MODEL // 2
POOL_GROUP_DIM = POOL_WIDTH // POOL_GROUPS
DN_HEADS = 8
DN_HEAD_DIM = 128
DN_WIDTH = DN_HEADS * DN_HEAD_DIM
CONV_WIDTH = 4
CHUNK = 64
PEER_HEADS = 8
N_KEYS = 128
N_EXPERTS = N_KEYS * N_KEYS
PEER_TOPK = 16
PEER_HALF = 128
PEER_QUERY_DIM = 2 * PEER_HALF
PEER_BLOCK = 64
SPLIT_POINTS = (
    POOL_WIDTH,
    POOL_WIDTH + 3 * DN_WIDTH,
    POOL_WIDTH + 4 * DN_WIDTH,
    POOL_WIDTH + 4 * DN_WIDTH + DN_HEADS,
    POOL_WIDTH + 4 * DN_WIDTH + 2 * DN_HEADS,
    POOL_WIDTH + 4 * DN_WIDTH + 2 * DN_HEADS + D_MODEL,
)
IN_COLS = POOL_WIDTH + 4 * DN_WIDTH + 2 * DN_HEADS + 2 * D_MODEL

kernel_name = "hybrid_pool_deltanet_peer_block"


def rmsnorm(x, w):
    xf = x.astype(jnp.float32)
    y = xf * lax.rsqrt(jnp.mean(xf * xf, axis=-1, keepdims=True) + EPS)
    return (y * w.astype(jnp.float32)).astype(x.dtype)


def l2norm(x):
    return x * lax.rsqrt(jnp.sum(x * x, axis=-1, keepdims=True) + EPS)


def pool_mixer(xa, pool_w, pool_scale):
    b, s, _ = xa.shape
    xf = xa.astype(jnp.float32)
    csum = jnp.cumsum(xf, axis=1)
    count = jnp.arange(1, s + 1, dtype=jnp.float32)[None, :, None]
    groups = []
    for g, win in enumerate(POOL_WINDOWS):
        sl = slice(g * POOL_GROUP_DIM, (g + 1) * POOL_GROUP_DIM)
        c = csum[..., sl]
        c_lag = jnp.pad(c, ((0, 0), (win, 0), (0, 0)))[:, :s]
        mean = (c - c_lag) / jnp.minimum(count, float(win))
        groups.append(mean - xf[..., sl])
    pooled = jnp.stack(groups, axis=2)
    y = jnp.einsum("bsgc,gcd->bsgd", pooled, pool_w.astype(jnp.float32))
    y = y.reshape(b, s, POOL_WIDTH) * pool_scale.astype(jnp.float32)
    return y.astype(xa.dtype)


def causal_dwconv(x, w):
    s = x.shape[1]
    k = w.shape[0]
    xp = jnp.pad(x, ((0, 0), (k - 1, 0), (0, 0)))
    y = xp[:, 0:s] * w[0]
    for j in range(1, k):
        y = y + xp[:, j:j + s] * w[j]
    return y


def gated_delta_rule(q, k, v, g, beta):
    b, h, s, dk = q.shape
    dv = v.shape[-1]
    nc = s // CHUNK
    q = q * (dk ** -0.5)
    k_beta = k * beta[..., None]
    v_beta = v * beta[..., None]

    def chunks(t):
        return t.reshape(b, h, nc, CHUNK, t.shape[-1])

    q, k, k_beta, v_beta = chunks(q), chunks(k), chunks(k_beta), chunks(v_beta)
    gc = jnp.cumsum(g.reshape(b, h, nc, CHUNK), axis=-1)
    tril = jnp.tril(jnp.ones((CHUNK, CHUNK), dtype=bool))
    strict = jnp.tril(jnp.ones((CHUNK, CHUNK), dtype=bool), -1)
    diff = gc[..., :, None] - gc[..., None, :]
    decay = jnp.where(tril, jnp.exp(jnp.where(tril, diff, 0.0)), 0.0)
    lower = jnp.where(strict, jnp.einsum("bhnid,bhnjd->bhnij", k_beta, k) * decay, 0.0)
    eye = jnp.eye(CHUNK, dtype=jnp.float32)
    t_inv = lax.linalg.triangular_solve(eye + lower, jnp.broadcast_to(eye, lower.shape),
                                        left_side=True, lower=True, unit_diagonal=True)
    u = jnp.einsum("bhnij,bhnjd->bhnid", t_inv, v_beta)
    w = jnp.einsum("bhnij,bhnjd->bhnid", t_inv, k_beta * jnp.exp(gc)[..., None])
    attn = jnp.where(tril, jnp.einsum("bhnid,bhnjd->bhnij", q, k) * decay, 0.0)

    def step(state, inp):
        q_i, k_i, u_i, w_i, a_i, g_i = inp
        v_new = u_i - jnp.einsum("bhcd,bhde->bhce", w_i, state)
        o = (jnp.einsum("bhcd,bhde->bhce", q_i * jnp.exp(g_i)[..., None], state)
             + jnp.einsum("bhij,bhje->bhie", a_i, v_new))
        g_last = g_i[..., -1]
        k_dec = k_i * jnp.exp(g_last[..., None] - g_i)[..., None]
        state = state * jnp.exp(g_last)[..., None, None] + jnp.einsum("bhcd,bhce->bhde", k_dec, v_new)
        return state, o

    xs = tuple(jnp.moveaxis(t, 2, 0) for t in (q, k, u, w, attn, gc))
    state0 = jnp.zeros((b, h, dk, dv), dtype=jnp.float32)
    _, o = lax.scan(step, state0, xs)
    return jnp.moveaxis(o, 0, 2).reshape(b, h, s, dv)


def deltanet_branch(qkv, z, beta_logit, a_logit, conv_w, a_log, dt_bias, dn_norm_w):
    b, s, _ = qkv.shape
    out_dtype = qkv.dtype
    f32 = jnp.float32
    qkv = jax.nn.silu(causal_dwconv(qkv.astype(f32), conv_w.astype(f32)))
    q, k, v = jnp.split(qkv, 3, axis=-1)

    def heads(t):
        return t.reshape(b, s, DN_HEADS, DN_HEAD_DIM).transpose(0, 2, 1, 3)

    q = l2norm(heads(q))
    k = l2norm(heads(k))
    v = heads(v)
    beta = jax.nn.sigmoid(beta_logit.astype(f32)).transpose(0, 2, 1)
    g = (-jnp.exp(a_log.astype(f32))
         * jax.nn.softplus(a_logit.astype(f32) + dt_bias.astype(f32))).transpose(0, 2, 1)
    o = gated_delta_rule(q, k, v, g, beta).transpose(0, 2, 1, 3)
    zf = z.astype(f32).reshape(b, s, DN_HEADS, DN_HEAD_DIM)
    o = rmsnorm(o, dn_norm_w) * jax.nn.silu(zf)
    return o.reshape(b, s, DN_WIDTH).astype(out_dtype)


def peer_ffn(x, w_query, keys_1, keys_2, expert_down, expert_up):
    b, s, d = x.shape
    f32 = jnp.float32
    q = (x @ w_query).astype(f32).reshape(b, s, PEER_HEADS, 2, PEER_HALF)
    s1 = jnp.einsum("bshc,hkc->bshk", q[..., 0, :], keys_1.astype(f32))
    s2 = jnp.einsum("bshc,hkc->bshk", q[..., 1, :], keys_2.astype(f32))
    v1, i1 = lax.top_k(s1, PEER_TOPK)
    v2, i2 = lax.top_k(s2, PEER_TOPK)
    cand_score = (v1[..., :, None] + v2[..., None, :]).reshape(b, s, PEER_HEADS, PEER_TOPK * PEER_TOPK)
    cand_idx = (i1[..., :, None] * N_KEYS + i2[..., None, :]).reshape(b, s, PEER_HEADS, PEER_TOPK * PEER_TOPK)
    top_score, pos = lax.top_k(cand_score, PEER_TOPK)
    experts = jnp.take_along_axis(cand_idx, pos, axis=-1)
    gates = jax.nn.softmax(top_score, axis=-1)

    nb = s // PEER_BLOCK
    xb = x.reshape(b, nb, PEER_BLOCK, d).transpose(1, 0, 2, 3)
    eb = experts.reshape(b, nb, PEER_BLOCK, PEER_HEADS, PEER_TOPK).transpose(1, 0, 2, 3, 4)
    gb = gates.reshape(b, nb, PEER_BLOCK, PEER_HEADS, PEER_TOPK).transpose(1, 0, 2, 3, 4)

    def block(args):
        xi, ei, gi = args
        u = jnp.take(expert_down, ei, axis=0)
        act = jax.nn.gelu(jnp.einsum("btd,bthkd->bthk", xi, u).astype(f32), approximate=False)
        vv = jnp.take(expert_up, ei, axis=0)
        return jnp.einsum("bthk,bthkd->btd", (gi * act).astype(x.dtype), vv)

    y = lax.map(block, (xb, eb, gb))
    return y.transpose(1, 0, 2, 3).reshape(b, s, d)


def setup_inputs(seed: int = 0) -> dict:
    key = jax.random.key(seed)
    ks = jax.random.split(key, 20)
    f32 = jnp.float32

    def nrm(k, shape, scale):
        return scale * jax.random.normal(k, shape, f32)

    def gain(k, shape):
        return 1.0 + 0.05 * jax.random.normal(k, shape, f32)

    dt = jnp.exp(jax.random.uniform(ks[7], (DEPTH, DN_HEADS), f32, math.log(1e-3), math.log(1e-1)))
    dt_bias = dt + jnp.log(-jnp.expm1(-dt))
    a_log = jnp.log(jax.random.uniform(ks[8], (DEPTH, DN_HEADS), f32, 1.0, 16.0))
    return {
        "x": jax.random.normal(ks[0], (BATCH, SEQ, D_MODEL), f32),
        "mix_norm_w": gain(ks[1], (DEPTH, D_MODEL)),
        "w_in": nrm(ks[2], (DEPTH, D_MODEL, IN_COLS), D_MODEL ** -0.5),
        "pool_w": nrm(ks[3], (DEPTH, POOL_GROUPS, POOL_GROUP_DIM, POOL_GROUP_DIM), POOL_GROUP_DIM ** -0.5),
        "pool_scale": 1.0 + 0.1 * jax.random.normal(ks[4], (DEPTH, POOL_WIDTH), f32),
        "conv_w": nrm(ks[5], (DEPTH, CONV_WIDTH, 3 * DN_WIDTH), CONV_WIDTH ** -0.5),
        "a_log": a_log,
        "dt_bias": dt_bias,
        "dn_norm_w": gain(ks[6], (DEPTH, DN_HEAD_DIM)),
        "w_pool_up": nrm(ks[9], (DEPTH, POOL_WIDTH, D_MODEL), POOL_WIDTH ** -0.5),
        "w_dn_up": nrm(ks[10], (DEPTH, DN_WIDTH, D_MODEL), DN_WIDTH ** -0.5),
        "w_mix_out": nrm(ks[11], (DEPTH, D_MODEL, D_MODEL), D_MODEL ** -0.5),
        "ffn_norm_w": gain(ks[12], (DEPTH, D_MODEL)),
        "peer_w_query": nrm(ks[13], (DEPTH, D_MODEL, PEER_HEADS * PEER_QUERY_DIM), D_MODEL ** -0.5),
        "peer_keys_1": nrm(ks[14], (DEPTH, PEER_HEADS, N_KEYS, PEER_HALF), PEER_HALF ** -0.5),
        "peer_keys_2": nrm(ks[15], (DEPTH, PEER_HEADS, N_KEYS, PEER_HALF), PEER_HALF ** -0.5),
        "peer_down": nrm(ks[16], (DEPTH, N_EXPERTS, D_MODEL), D_MODEL ** -0.5),
        "peer_up": nrm(ks[17], (DEPTH, N_EXPERTS, D_MODEL), PEER_HEADS ** -0.5),
        "final_norm_w": gain(ks[18], (D_MODEL,)),
    }


def reference(x, mix_norm_w, w_in, pool_w, pool_scale, conv_w, a_log, dt_bias, dn_norm_w,
              w_pool_up, w_dn_up, w_mix_out, ffn_norm_w, peer_w_query, peer_keys_1,
              peer_keys_2, peer_down, peer_up, final_norm_w):
    h = x
    for l in range(DEPTH):
        xn = rmsnorm(h, mix_norm_w[l])
        proj = xn @ w_in[l]
        xa, qkv, z, beta_logit, a_logit, gate_a, gate_b = jnp.split(proj, SPLIT_POINTS, axis=-1)
        y_a = pool_mixer(xa, pool_w[l], pool_scale[l]) @ w_pool_up[l]
        y_b = deltanet_branch(qkv, z, beta_logit, a_logit, conv_w[l], a_log[l], dt_bias[l],
                              dn_norm_w[l]) @ w_dn_up[l]
        merged = jax.nn.sigmoid(gate_a) * y_a + jax.nn.sigmoid(gate_b) * y_b
        h = h + merged @ w_mix_out[l]
        h = h + peer_ffn(rmsnorm(h, ffn_norm_w[l]), peer_w_query[l], peer_keys_1[l],
                         peer_keys_2[l], peer_down[l], peer_up[l])
    return rmsnorm(h, final_norm_w)
```

```cpp
#include <hip/hip_runtime.h>
#include <hip/hip_cooperative_groups.h>
#include <cstdio>
#include <cstdint>
namespace cg = cooperative_groups;
namespace pg8 {
#define PG8_LAS __attribute__((address_space(3)))
typedef unsigned short bf16_t;
typedef short bf16x8 __attribute__((ext_vector_type(8)));
typedef float f32x4 __attribute__((ext_vector_type(4)));
typedef unsigned u32x4 __attribute__((ext_vector_type(4)));
constexpr int BM = 256, BK = 64, HALF = 128, HTB = HALF * BK * 2  , STAGE_BYTES = 8 * HTB, NXCD = 8, WGM = 8;

__host__ __device__ __forceinline__ int lds_byte(int r, int c) { const int st = (r >> 4) * 2 + (c >> 5), rr = r & 15, cc = c & 31, ob = rr * 64 + cc * 2; return st * 1024 + (ob ^ (((ob >> 9) & 1) << 5)); }
__host__ __device__ __forceinline__ void stage_rc(int b, int& R, int& C) { const int st = b / 1024, sb = b % 1024, swz = sb ^ (((sb >> 9) & 1) << 5); R = (st >> 1) * 16 + swz / 64; C = (st & 1) * 32 + (swz % 64) / 2; }
__host__ __device__ __forceinline__ int perm32(int rho) { const int n = rho >> 4, i = rho & 15; return 8 * (i >> 2) + 4 * n + (i & 3); }

struct Unit { int pm, pn; };
struct Gemm { const bf16_t* A; const bf16_t* Bt; int M, N, K, lda, ldb; };

struct StaticOrder {
    int nM, nN, nwg, G, c;
    __host__ __device__ void init(int M, int N, int G_, int c_) { nM = M / BM; nN = N / BM; nwg = nM * nN; G = G_; c = c_; }
    __host__ __device__ bool next(int i, Unit& u) const {
        const long L = (long)i * G + c; if (L >= nwg) return false;
        int wgid = (int)L; { const int q = nwg / NXCD, r = nwg % NXCD, xcd = wgid % NXCD, off = wgid / NXCD; wgid = (xcd < r ? xcd * (q + 1) : r * (q + 1) + (xcd - r) * q) + off; }
        const int nig = WGM * nN, gid = wgid / nig, fm = gid * WGM, gsz = (nM - fm) < WGM ? (nM - fm) : WGM;
        u.pm = fm + ((wgid % nig) % gsz); u.pn = (wgid % nig) / gsz; return true;
    }
    __device__ __forceinline__ void a_ready(const Unit&) const {}
    __device__ __forceinline__ void done(const Unit&) const {}
};

typedef float f32x2_t __attribute__((ext_vector_type(2))); typedef __bf16 bf16x2_t __attribute__((ext_vector_type(2)));
__device__ __forceinline__ unsigned cvt_pk_bf16(float lo, float hi) { const f32x2_t v = {lo, hi}; const bf16x2_t b = __builtin_convertvector(v, bf16x2_t); return __builtin_bit_cast(unsigned, b); }
__device__ __forceinline__ float bf_lo(unsigned w) { return __uint_as_float(w << 16); }
__device__ __forceinline__ float bf_hi(unsigned w) { return __uint_as_float(w & 0xffff0000u); }
__device__ __forceinline__ float sigmoidf_(float x) { return 1.0f / (1.0f + __expf(-x)); }

template <int ACT> struct EpiStore {
    static constexpr bool PERM = true, AFTER_DRAIN = false;
    bf16_t* O; bf16_t* O2; int ldc; int split_cols;
    __device__ __forceinline__ void operator()(const f32x4 (&acc)[2][2][4][2], const Unit& u, int wr, int wc, int fr, int fq) const {
        const int row0 = u.pm * BM + wr * 64 + fr; int colt = u.pn * BM; bf16_t* base = O;
        if (split_cols && colt >= split_cols) { base = O2; colt -= split_cols; }
        const int col0 = colt + wc * 32 + 8 * fq;
#pragma unroll
        for (int ai = 0; ai < 2; ++ai)
#pragma unroll
            for (int m = 0; m < 4; ++m) { bf16_t* rowp = base + (size_t)(row0 + ai * HALF + m * 16) * ldc + col0;
#pragma unroll
                for (int bj = 0; bj < 2; ++bj) { f32x4 v0 = acc[ai][bj][m][0], v1 = acc[ai][bj][m][1];
                    if (ACT == 1) {
#pragma unroll
                        for (int e = 0; e < 4; ++e) { v0[e] = sigmoidf_(v0[e]); v1[e] = sigmoidf_(v1[e]); } }
                    u32x4 w; w.x = cvt_pk_bf16(v0[0], v0[1]); w.y = cvt_pk_bf16(v0[2], v0[3]); w.z = cvt_pk_bf16(v1[0], v1[1]); w.w = cvt_pk_bf16(v1[2], v1[3]);
                    *(u32x4*)(rowp + bj * HALF) = w; } }
    }
};
template <bool ADD> struct EpiGateMul {
    static constexpr bool PERM = true, AFTER_DRAIN = false;
    bf16_t* MG; const bf16_t* G; int ld;
    __device__ __forceinline__ void operator()(const f32x4 (&acc)[2][2][4][2], const Unit& u, int wr, int wc, int fr, int fq) const {
        const int row0 = u.pm * BM + wr * 64 + fr; const int col0 = u.pn * BM + wc * 32 + 8 * fq;
#pragma unroll
        for (int ai = 0; ai < 2; ++ai)
#pragma unroll
            for (int m = 0; m < 4; ++m) { const size_t off = (size_t)(row0 + ai * HALF + m * 16) * ld + col0;
#pragma unroll
                for (int bj = 0; bj < 2; ++bj) { const f32x4 v0 = acc[ai][bj][m][0], v1 = acc[ai][bj][m][1];
                    const u32x4 g = *(const u32x4*)(G + off + bj * HALF);
                    float o[8];
                    o[0] = bf_lo(g.x) * v0[0]; o[1] = bf_hi(g.x) * v0[1]; o[2] = bf_lo(g.y) * v0[2]; o[3] = bf_hi(g.y) * v0[3];
                    o[4] = bf_lo(g.z) * v1[0]; o[5] = bf_hi(g.z) * v1[1]; o[6] = bf_lo(g.w) * v1[2]; o[7] = bf_hi(g.w) * v1[3];
                    if (ADD) { const u32x4 p = *(const u32x4*)(MG + off + bj * HALF);
                        o[0] += bf_lo(p.x); o[1] += bf_hi(p.x); o[2] += bf_lo(p.y); o[3] += bf_hi(p.y); o[4] += bf_lo(p.z); o[5] += bf_hi(p.z); o[6] += bf_lo(p.w); o[7] += bf_hi(p.w); }
                    u32x4 w; w.x = cvt_pk_bf16(o[0], o[1]); w.y = cvt_pk_bf16(o[2], o[3]); w.z = cvt_pk_bf16(o[4], o[5]); w.w = cvt_pk_bf16(o[6], o[7]);
                    *(u32x4*)(MG + off + bj * HALF) = w; }
                asm volatile("" ::: "memory"); }
    }
};
struct EpiResid {
    static constexpr bool PERM = true, AFTER_DRAIN = false;
    const float* X; float* H; bf16_t* HB; float* SSQ; int ld;
    __device__ __forceinline__ void operator()(const f32x4 (&acc)[2][2][4][2], const Unit& u, int wr, int wc, int fr, int fq) const {
        const int row0 = u.pm * BM + wr * 64 + fr; const int col0 = u.pn * BM + wc * 32 + 8 * fq;
#pragma unroll
        for (int ai = 0; ai < 2; ++ai)
#pragma unroll
            for (int m = 0; m < 4; ++m) { const int row = row0 + ai * HALF + m * 16; const size_t off = (size_t)row * ld + col0; float ss = 0.f;
#pragma unroll
                for (int bj = 0; bj < 2; ++bj) {
                    const f32x4 x0 = *(const f32x4*)(X + off + bj * HALF), x1 = *(const f32x4*)(X + off + bj * HALF + 4);
                    const f32x4 h0 = x0 + acc[ai][bj][m][0], h1 = x1 + acc[ai][bj][m][1];
                    *(f32x4*)(H + off + bj * HALF) = h0; *(f32x4*)(H + off + bj * HALF + 4) = h1;
                    u32x4 w; w.x = cvt_pk_bf16(h0[0], h0[1]); w.y = cvt_pk_bf16(h0[2], h0[3]); w.z = cvt_pk_bf16(h1[0], h1[1]); w.w = cvt_pk_bf16(h1[2], h1[3]);
                    *(u32x4*)(HB + off + bj * HALF) = w;
                    ss += (h0[0] * h0[0] + h0[1] * h0[1]) + (h0[2] * h0[2] + h0[3] * h0[3]) + (h1[0] * h1[0] + h1[1] * h1[1]) + (h1[2] * h1[2] + h1[3] * h1[3]); }
                ss += __shfl_xor(ss, 16); ss += __shfl_xor(ss, 32);
                if (fq == 0) SSQ[(size_t)row * 16 + u.pn * 4 + wc] = ss;
                asm volatile("" ::: "memory"); }
    }
};
struct EpiRowScale {
    static constexpr bool PERM = true, AFTER_DRAIN = false;
    bf16_t* O; const float* SSQ; int ldc; float inv_n, eps;
    __device__ __forceinline__ void operator()(const f32x4 (&acc)[2][2][4][2], const Unit& u, int wr, int wc, int fr, int fq) const {
        const int row0 = u.pm * BM + wr * 64 + fr; const int col0 = u.pn * BM + wc * 32 + 8 * fq;
#pragma unroll
        for (int ai = 0; ai < 2; ++ai)
#pragma unroll
            for (int m = 0; m < 4; ++m) { const int row = row0 + ai * HALF + m * 16; const f32x4* sp = (const f32x4*)(SSQ + (size_t)row * 16); const f32x4 s4 = (sp[0] + sp[1]) + (sp[2] + sp[3]); const float sc = 1.0f / sqrtf(((s4[0] + s4[1]) + (s4[2] + s4[3])) * inv_n + eps);
                bf16_t* rowp = O + (size_t)row * ldc + col0;
#pragma unroll
                for (int bj = 0; bj < 2; ++bj) { const f32x4 v0 = acc[ai][bj][m][0] * sc, v1 = acc[ai][bj][m][1] * sc;
                    u32x4 w; w.x = cvt_pk_bf16(v0[0], v0[1]); w.y = cvt_pk_bf16(v0[2], v0[3]); w.z = cvt_pk_bf16(v1[0], v1[1]); w.w = cvt_pk_bf16(v1[2], v1[3]);
                    *(u32x4*)(rowp + bj * HALF) = w; } }
    }
};

template <class Epi, class Sched, bool ALIGN_EPI = false, bool SP2 = false>
__device__ __forceinline__ void gemm_phase(PG8_LAS unsigned char* lds, const Gemm g, const Sched& S, const Epi& E) {
    int tid_ = threadIdx.x; asm volatile("" : "+v"(tid_));
    const int tid = tid_, wid = __builtin_amdgcn_readfirstlane(tid >> 6), lane = tid & 63, wr = wid >> 2, wc = wid & 3, fr = lane & 15, fq = lane >> 4;
    const int K = g.K, nt = K / BK;
    unsigned voffA[2], voffB[2];
#pragma unroll
    for (int i = 0; i < 2; ++i) { int R, C; stage_rc(tid * 16 + i * 8192, R, C); const int Rb = Epi::PERM ? ((R & ~31) + perm32(R & 31)) : R;
        voffA[i] = (unsigned)(R * g.lda + C) * 2u; voffB[i] = (unsigned)(Rb * g.ldb + C) * 2u; }
    const size_t kstep = (size_t)(BK * 2);
    const size_t hstepA = (size_t)HALF * g.lda * 2, hstepB = (size_t)HALF * g.ldb * 2;
    const size_t tstepA = 2 * hstepA, tstepB = 2 * hstepB;
    const unsigned ldsw = (unsigned)wid * 1024u;
    const int aoff = lds_byte(wr * 64 + fr, fq * 8), boff = lds_byte(wc * 32 + fr, fq * 8);
#define PG8_SA(b, h) (((b) * 2 + (h)) * HTB)
#define PG8_SB(b, h) ((4 + (b) * 2 + (h)) * HTB)
#define PG8_STAGE(bufoff, gbase, voff) do { _Pragma("unroll") for (int _i = 0; _i < 2; ++_i) \
        __builtin_amdgcn_global_load_lds((const unsigned*)((const char*)(gbase) + (voff)[_i]), (PG8_LAS unsigned*)(lds + (bufoff) + ldsw + _i * 8192), 16, 0, 0); } while (0)
#define PG8_LDA(dst, b, h) do { _Pragma("unroll") for (int m = 0; m < 4; ++m) _Pragma("unroll") for (int k = 0; k < 2; ++k) dst[m][k] = *(const PG8_LAS bf16x8*)(lds + PG8_SA(b, h) + aoff + m * 2048 + k * 1024); } while (0)
#define PG8_LDB(dst, b, h) do { _Pragma("unroll") for (int n = 0; n < 2; ++n) _Pragma("unroll") for (int k = 0; k < 2; ++k) dst[n][k] = *(const PG8_LAS bf16x8*)(lds + PG8_SB(b, h) + boff + n * 2048 + k * 1024); } while (0)
#define PG8_MMA(ai, bj, At, Bt) do { __builtin_amdgcn_s_setprio(1); _Pragma("unroll") for (int m = 0; m < 4; ++m) _Pragma("unroll") for (int n = 0; n < 2; ++n) _Pragma("unroll") for (int k = 0; k < 2; ++k) \
        acc[ai][bj][m][n] = __builtin_amdgcn_mfma_f32_16x16x32_bf16(Bt[n][k], At[m][k], acc[ai][bj][m][n], 0, 0, 0); __builtin_amdgcn_s_setprio(0); } while (0)
#define PG8_WAIT_V(n) asm volatile("s_waitcnt vmcnt(" #n ")" ::: "memory")
#define PG8_WAIT_L(n) asm volatile("s_waitcnt lgkmcnt(" #n ")" ::: "memory")
#define PG8_BAR __builtin_amdgcn_s_barrier()
#define PG8_SCHED __builtin_amdgcn_sched_barrier(0)
    Unit cur, nxt; int ui = 0;
    if (!S.next(0, cur)) return;
    f32x4 acc[2][2][4][2];
#pragma unroll
    for (int a = 0; a < 2; ++a)
#pragma unroll
        for (int b = 0; b < 2; ++b)
#pragma unroll
            for (int m = 0; m < 4; ++m)
#pragma unroll
                for (int n = 0; n < 2; ++n) acc[a][b][m][n] = (f32x4){0.f, 0.f, 0.f, 0.f};
    bf16x8 At[4][2], B0[2][2], B1[2][2];
    const char* cA = (const char*)g.A + (size_t)cur.pm * tstepA; const char* cB = (const char*)g.Bt + (size_t)cur.pn * tstepB;
    S.a_ready(cur);
    if constexpr (SP2) {
        PG8_STAGE(PG8_SB(0, 0), cB, voffB); PG8_STAGE(PG8_SB(0, 1), cB + hstepB, voffB); PG8_STAGE(PG8_SA(0, 0), cA, voffA); PG8_STAGE(PG8_SA(0, 1), cA + hstepA, voffA);
        if (wr == 1) PG8_BAR;
        PG8_WAIT_V(2); PG8_BAR;
        PG8_STAGE(PG8_SB(1, 0), cB + kstep, voffB); PG8_STAGE(PG8_SA(1, 0), cA + kstep, voffA); PG8_STAGE(PG8_SB(1, 1), cB + hstepB + kstep, voffB);
        PG8_WAIT_V(6); PG8_BAR;
    } else {
        PG8_STAGE(PG8_SB(0, 0), cB, voffB); PG8_STAGE(PG8_SA(0, 0), cA, voffA); PG8_STAGE(PG8_SB(0, 1), cB + hstepB, voffB); PG8_STAGE(PG8_SA(0, 1), cA + hstepA, voffA);
        if (wr == 1) PG8_BAR;
        PG8_WAIT_V(4); PG8_BAR;
        PG8_STAGE(PG8_SB(1, 0), cB + kstep, voffB); PG8_STAGE(PG8_SA(1, 0), cA + kstep, voffA); PG8_STAGE(PG8_SB(1, 1), cB + hstepB + kstep, voffB);
        PG8_WAIT_V(6); PG8_BAR;
    }
    for (;;) {
        const bool has_next = S.next(ui + 1, nxt);
        const char* nA = has_next ? (const char*)g.A + (size_t)nxt.pm * tstepA : cA; const char* nB = has_next ? (const char*)g.Bt + (size_t)nxt.pn * tstepB : cB;
        for (int t = 0; t < nt; t += 2) {
            const bool last = (t == nt - 2);
            const char* a1 = cA + (size_t)(t + 1) * kstep;
            const char* a2 = last ? nA : cA + (size_t)(t + 2) * kstep; const char* b2 = last ? nB : cB + (size_t)(t + 2) * kstep;
            const char* a3 = a2 + kstep; const char* b3 = b2 + kstep;
            if (last && has_next) S.a_ready(nxt);
            if constexpr (SP2) {
            PG8_LDB(B0, 0, 0); PG8_LDB(B1, 0, 1); PG8_SCHED; PG8_LDA(At, 0, 0); PG8_STAGE(PG8_SA(1, 1), a1 + hstepA, voffA);
            PG8_WAIT_V(8); PG8_WAIT_L(0); PG8_BAR; PG8_MMA(0, 0, At, B0); PG8_MMA(0, 1, At, B1); PG8_BAR; PG8_SCHED;
            PG8_LDA(At, 0, 1); PG8_STAGE(PG8_SB(0, 0), b2, voffB); PG8_STAGE(PG8_SB(0, 1), b2 + hstepB, voffB); PG8_STAGE(PG8_SA(0, 0), a2, voffA);
            PG8_WAIT_V(8); PG8_WAIT_L(0); PG8_BAR; PG8_MMA(1, 0, At, B0); PG8_MMA(1, 1, At, B1); PG8_BAR; PG8_SCHED;
            PG8_LDB(B0, 1, 0); PG8_LDB(B1, 1, 1); PG8_SCHED; PG8_LDA(At, 1, 0); PG8_STAGE(PG8_SA(0, 1), a2 + hstepA, voffA);
            PG8_WAIT_V(8); PG8_WAIT_L(0); PG8_BAR; PG8_MMA(0, 0, At, B0); PG8_MMA(0, 1, At, B1); PG8_BAR; PG8_SCHED;
            PG8_LDA(At, 1, 1); PG8_STAGE(PG8_SB(1, 0), b3, voffB); PG8_STAGE(PG8_SB(1, 1), b3 + hstepB, voffB); PG8_STAGE(PG8_SA(1, 0), a3, voffA);
            PG8_WAIT_V(8); PG8_WAIT_L(0); PG8_BAR; PG8_MMA(1, 0, At, B0); PG8_MMA(1, 1, At, B1); PG8_BAR; PG8_SCHED;
            } else {
            PG8_LDB(B0, 0, 0); PG8_SCHED; PG8_LDA(At, 0, 0); PG8_STAGE(PG8_SA(1, 1), a1 + hstepA, voffA);
            PG8_WAIT_L(8); PG8_BAR; PG8_WAIT_L(0); PG8_MMA(0, 0, At, B0); PG8_BAR; PG8_SCHED;
            PG8_LDB(B1, 0, 1); PG8_STAGE(PG8_SB(0, 0), b2, voffB);
            PG8_BAR; PG8_WAIT_L(0); PG8_MMA(0, 1, At, B1); PG8_BAR;
            PG8_LDA(At, 0, 1); PG8_STAGE(PG8_SA(0, 0), a2, voffA);
            PG8_BAR; PG8_WAIT_L(0); PG8_MMA(1, 0, At, B0); PG8_BAR; PG8_SCHED;
            PG8_STAGE(PG8_SB(0, 1), b2 + hstepB, voffB);
            PG8_WAIT_V(6); PG8_BAR; PG8_MMA(1, 1, At, B1); PG8_BAR;
            PG8_LDB(B0, 1, 0); PG8_SCHED; PG8_LDA(At, 1, 0); PG8_STAGE(PG8_SA(0, 1), a2 + hstepA, voffA);
            PG8_WAIT_L(8); PG8_BAR; PG8_WAIT_L(0); PG8_MMA(0, 0, At, B0); PG8_BAR; PG8_SCHED;
            PG8_LDB(B1, 1, 1); PG8_STAGE(PG8_SB(1, 0), b3, voffB);
            PG8_BAR; PG8_WAIT_L(0); PG8_MMA(0, 1, At, B1); PG8_BAR;
            PG8_LDA(At, 1, 1); PG8_STAGE(PG8_SA(1, 0), a3, voffA);
            PG8_BAR; PG8_WAIT_L(0); PG8_MMA(1, 0, At, B0); PG8_BAR; PG8_SCHED;
            PG8_STAGE(PG8_SB(1, 1), b3 + hstepB, voffB);
            PG8_WAIT_V(6); PG8_BAR; PG8_MMA(1, 1, At, B1); PG8_BAR;
            }
        }
        if constexpr (ALIGN_EPI) { if (wr == 0) PG8_BAR; }
        if constexpr (!Epi::AFTER_DRAIN) { E(acc, cur, wr, wc, fr, fq); S.done(cur); }
        if (!has_next) break;
#pragma unroll
        for (int a = 0; a < 2; ++a)
#pragma unroll
            for (int b = 0; b < 2; ++b)
#pragma unroll
                for (int m = 0; m < 4; ++m)
#pragma unroll
                    for (int n = 0; n < 2; ++n) acc[a][b][m][n] = (f32x4){0.f, 0.f, 0.f, 0.f};
        cur = nxt; cA = nA; cB = nB; ++ui;
        if constexpr (ALIGN_EPI) { if (wr == 1) PG8_BAR; }
    }
    PG8_WAIT_V(0);
    if constexpr (!ALIGN_EPI) { if (wr == 0) PG8_BAR; }
    PG8_BAR;
    if constexpr (Epi::AFTER_DRAIN) { E.fused(acc, cur, wr, wc, fr, fq, lds, wid, lane); S.done(cur); }
#undef PG8_SA
#undef PG8_SB
#undef PG8_STAGE
#undef PG8_LDA
#undef PG8_LDB
#undef PG8_MMA
#undef PG8_WAIT_V
#undef PG8_WAIT_L
#undef PG8_BAR
#undef PG8_SCHED
}
}

constexpr int NTOK = 65536, SEQ = 8192, NBATCH = 8, DM = 1024, INC = 6672, P1N = 4608, NCHUNK = SEQ / 64;
constexpr float EPS = 1e-6f;
constexpr int NWAVES = 8, NTHREADS = 512;
constexpr int LDS_BYTES = 147456;
constexpr size_t MiB = (size_t)1 << 20;
constexpr size_t WS_SSQ = 1008 * MiB;
constexpr size_t WS_KEYS = 1 * MiB;
constexpr size_t WS_POOLW = 1 * MiB + 512 * 1024;
constexpr size_t WS_WPU = 2 * MiB, WS_WDU = 3 * MiB, WS_WMX = 5 * MiB, WS_WQ = 7 * MiB, WS_WIN = 11 * MiB;
constexpr size_t WS_EDOWN = 24 * MiB, WS_EUP = 56 * MiB;
constexpr size_t WS_BETA = 88 * MiB, WS_GRAW = 90 * MiB, WS_GC = 92 * MiB;
constexpr size_t WS_HALO = 94 * MiB;
constexpr size_t WS_POOLED = 112 * MiB;
constexpr size_t WS_WBUF = 176 * MiB;
constexpr size_t WS_ABUF = 304 * MiB;
constexpr size_t WS_PROJ = 432 * MiB;
constexpr size_t WS_Q2 = WS_PROJ, WS_IDX = WS_PROJ + 256 * MiB, WS_GATEW = WS_PROJ + 288 * MiB;
constexpr size_t WS_END = 1012 * MiB;
constexpr int C_XA = 0, C_Q = 512, C_K = 1536, C_V = 2560, C_Z = 3584;

#define LAS __attribute__((address_space(3)))
typedef unsigned short bf16_t;
typedef short bf16x8 __attribute__((ext_vector_type(8)));
typedef float f32x4 __attribute__((ext_vector_type(4)));
typedef unsigned u32x4 __attribute__((ext_vector_type(4)));
typedef unsigned u32x2 __attribute__((ext_vector_type(2)));
#define LDS_WAIT() asm volatile("s_waitcnt lgkmcnt(0)" ::: "memory")
#define VM_WAIT() asm volatile("s_waitcnt vmcnt(0)" ::: "memory")

__device__ __forceinline__ unsigned pk2(float lo, float hi) { return pg8::cvt_pk_bf16(lo, hi); }
__device__ __forceinline__ unsigned short f2bf(float f) { return (unsigned short)(pg8::cvt_pk_bf16(f, 0.f) & 0xffffu); }
__device__ __forceinline__ float bflo(unsigned w) { return __uint_as_float(w << 16); }
__device__ __forceinline__ float bfhi(unsigned w) { return __uint_as_float(w & 0xffff0000u); }
__device__ __forceinline__ float bf2f(unsigned short b) { return __uint_as_float((unsigned)b << 16); }
__device__ __forceinline__ void unpack8(const u32x4 w, float* f) { f[0] = bflo(w.x); f[1] = bfhi(w.x); f[2] = bflo(w.y); f[3] = bfhi(w.y); f[4] = bflo(w.z); f[5] = bfhi(w.z); f[6] = bflo(w.w); f[7] = bfhi(w.w); }
__device__ __forceinline__ u32x4 pack8(const float* f) { u32x4 w; w.x = pk2(f[0], f[1]); w.y = pk2(f[2], f[3]); w.z = pk2(f[4], f[5]); w.w = pk2(f[6], f[7]); return w; }
__device__ __forceinline__ float wave_sum(float v) {
#pragma unroll
    for (int o = 1; o < 64; o <<= 1) v += __shfl_xor(v, o);
    return v;
}
__device__ __forceinline__ f32x4 mfma16(bf16x8 a, bf16x8 b, f32x4 c) { return __builtin_amdgcn_mfma_f32_16x16x32_bf16(a, b, c, 0, 0, 0); }
__device__ __forceinline__ bf16x8 ldfrag(const LAS bf16_t* p, int ld, int row0, int k0, int lane) { return *(const LAS bf16x8*)(p + (row0 + (lane & 15)) * ld + k0 + 8 * (lane >> 4)); }

struct Params { const float* in[19]; float* out; unsigned char* ws; };

struct Frame {
    LAS unsigned char* lds;
    int tid, lane, wave, vcu, G;
    __device__ __forceinline__ void fresh() { int t = threadIdx.x; asm volatile("" : "+v"(t)); tid = t; lane = t & 63; wave = __builtin_amdgcn_readfirstlane(t >> 6); }
    const float *x, *mix_norm_w, *w_in, *pool_w, *pool_scale, *conv_w, *a_log, *dt_bias, *dn_norm_w, *w_pool_up, *w_dn_up, *w_mix_out, *ffn_norm_w, *w_query, *keys1, *keys2, *peer_down, *peer_up, *final_norm_w;
    float* out; unsigned char* ws;
};

__device__ __forceinline__ void p0_transpose_item(const float* W, int ldw, int c0, const float* kscale, int K, bf16_t* WT, int nblk, LAS float* scr, int item, int lane) {
    const int kb = item / nblk, nb = item % nblk, k0 = 64 * kb, n0 = 32 * nb;
#pragma unroll 8
    for (int i = 0; i < 32; ++i) { const int kk = 2 * i + (lane >> 5); float v = W[(size_t)(k0 + kk) * ldw + c0 + n0 + (lane & 31)]; if (kscale) v *= kscale[k0 + kk]; scr[kk * 33 + (lane & 31)] = v; }
    LDS_WAIT();
    const int c = lane & 7;
#pragma unroll
    for (int j = 0; j < 4; ++j) { const int n = (lane >> 3) + 8 * j; const LAS float* s = scr + (8 * c) * 33 + n;
        u32x4 o; o.x = pk2(s[0 * 33], s[1 * 33]); o.y = pk2(s[2 * 33], s[3 * 33]); o.z = pk2(s[4 * 33], s[5 * 33]); o.w = pk2(s[6 * 33], s[7 * 33]);
        *(u32x4*)(WT + (size_t)(n0 + n) * K + k0 + 8 * c) = o; }
    LDS_WAIT();
}
__device__ __forceinline__ float softplusf_(float x) { return x > 15.f ? x : log1pf(expf(x)); }

__device__ __forceinline__ void p0_prologue(Frame& F) {
    F.fresh();
    const int gw = F.vcu * NWAVES + F.wave, NGW = F.G * NWAVES;
    const int gt = F.vcu * NTHREADS + F.tid, NGT = F.G * NTHREADS;
    unsigned char* ws = F.ws;
    {
        LAS float* scr = (LAS float*)(F.lds + F.wave * 8448);
        constexpr int I_IN1 = 16 * (P1N / 32), I_IN2 = 16 * (2048 / 32), I_PU = 8 * 32, I_DU = 16 * 32, I_MX = 16 * 32, I_WQ = 16 * 64, I_PW = 4 * 2 * 4;
        constexpr int NITEMS = I_IN1 + I_IN2 + I_PU + I_DU + I_MX + I_WQ + I_PW;
        bf16_t* WIN = (bf16_t*)(ws + WS_WIN);
#pragma unroll 1
        for (int it = gw; it < NITEMS; it += NGW) {
            int r = it;
            if (r < I_IN1) { p0_transpose_item(F.w_in, INC, 0, nullptr, DM, WIN, P1N / 32, scr, r, F.lane); continue; } r -= I_IN1;
            if (r < I_IN2) { p0_transpose_item(F.w_in, INC, 4624, nullptr, DM, WIN + (size_t)P1N * DM, 2048 / 32, scr, r, F.lane); continue; } r -= I_IN2;
            if (r < I_PU) { p0_transpose_item(F.w_pool_up, DM, 0, nullptr, 512, (bf16_t*)(ws + WS_WPU), 32, scr, r, F.lane); continue; } r -= I_PU;
            if (r < I_DU) { p0_transpose_item(F.w_dn_up, DM, 0, nullptr, DM, (bf16_t*)(ws + WS_WDU), 32, scr, r, F.lane); continue; } r -= I_DU;
            if (r < I_MX) { p0_transpose_item(F.w_mix_out, DM, 0, nullptr, DM, (bf16_t*)(ws + WS_WMX), 32, scr, r, F.lane); continue; } r -= I_MX;
            if (r < I_WQ) { p0_transpose_item(F.w_query, 2048, 0, F.ffn_norm_w, DM, (bf16_t*)(ws + WS_WQ), 64, scr, r, F.lane); continue; } r -= I_WQ;
            { const int g = r >> 3, rr = r & 7; p0_transpose_item(F.pool_w + (size_t)g * 128 * 128, 128, 0, nullptr, 128, (bf16_t*)(ws + WS_POOLW) + (size_t)g * 128 * 128, 4, scr, rr, F.lane); }
        }
    }
    {
        bf16_t* KEYS = (bf16_t*)(ws + WS_KEYS);
#pragma unroll 1
        for (int i = gt; i < 2 * 8 * 128 * 128 / 4; i += NGT) {
            const int e = i * 4; const int p = e / (8 * 128 * 128), r = e % (8 * 128 * 128), h = r / (128 * 128), q = r % (128 * 128);
            const f32x4 v = *(const f32x4*)((p ? F.keys2 : F.keys1) + r);
            u32x2 o; o.x = pk2(v[0], v[1]); o.y = pk2(v[2], v[3]);
            *(u32x2*)(KEYS + ((size_t)(h * 2 + p) * 128 * 128 + q)) = o;
        }
    }
    {
        bf16_t* ED = (bf16_t*)(ws + WS_EDOWN); bf16_t* EU = (bf16_t*)(ws + WS_EUP);
#pragma unroll 4
        for (int i = gt; i < 16384 * 1024 / 4; i += NGT) {
            const size_t e = (size_t)i * 4; const int k = (int)(e & 1023);
            const f32x4 nw = *(const f32x4*)(F.ffn_norm_w + k);
            const f32x4 d = *(const f32x4*)(F.peer_down + e) * nw; const f32x4 u = *(const f32x4*)(F.peer_up + e);
            u32x2 o; o.x = pk2(d[0], d[1]); o.y = pk2(d[2], d[3]); *(u32x2*)(ED + e) = o;
            u32x2 o2; o2.x = pk2(u[0], u[1]); o2.y = pk2(u[2], u[3]); *(u32x2*)(EU + e) = o2;
        }
    }
    __syncthreads();
    {
        LAS float* wbd = (LAS float*)F.lds;
        for (int i = F.tid; i < 16 * 1024; i += NTHREADS) { const int c = i & 15, k = i >> 4; wbd[c * 1024 + k] = F.w_in[(size_t)k * INC + 4608 + c]; }
        __syncthreads();
        bf16_t* XN = (bf16_t*)F.out;
        float* BETA = (float*)(ws + WS_BETA); float* GRAW = (float*)(ws + WS_GRAW);
        f32x4 nw[4];
#pragma unroll
        for (int j = 0; j < 4; ++j) nw[j] = *((const f32x4*)F.mix_norm_w + F.lane + 64 * j);
        const int hh = F.lane & 7;
        const float alog_e = expf(F.a_log[hh]), dtb = F.dt_bias[hh];
#pragma unroll 1
        for (int m = gw; m < NTOK; m += NGW) {
            const f32x4* xr = (const f32x4*)(F.x + (size_t)m * DM) + F.lane;
            f32x4 v[4]; float s = 0.f;
#pragma unroll
            for (int j = 0; j < 4; ++j) { v[j] = xr[64 * j]; s += (v[j][0] * v[j][0] + v[j][1] * v[j][1]) + (v[j][2] * v[j][2] + v[j][3] * v[j][3]); }
            const float rstd = 1.0f / sqrtf(wave_sum(s) * (1.f / DM) + EPS);
            unsigned long long* o8 = (unsigned long long*)(XN + (size_t)m * DM) + F.lane;
#pragma unroll
            for (int j = 0; j < 4; ++j) { v[j] = v[j] * rstd * nw[j]; o8[64 * j] = (unsigned long long)pk2(v[j][0], v[j][1]) | ((unsigned long long)pk2(v[j][2], v[j][3]) << 32); }
            float mine = 0.f;
#pragma unroll 2
            for (int c = 0; c < 16; ++c) {
                float a = 0.f;
#pragma unroll
                for (int j = 0; j < 4; ++j) { const f32x4 w4 = *(const LAS f32x4*)(wbd + c * 1024 + 256 * j + 4 * F.lane); a += (v[j][0] * w4[0] + v[j][1] * w4[1]) + (v[j][2] * w4[2] + v[j][3] * w4[3]); }
                a = wave_sum(a);
                mine = (F.lane == c) ? a : mine;
            }
            if (F.lane < 8) BETA[(size_t)m * 8 + F.lane] = 1.0f / (1.0f + expf(-mine));
            else if (F.lane < 16) GRAW[(size_t)m * 8 + hh] = -alog_e * softplusf_(mine + dtb);
        }
    }
}

__device__ __forceinline__ void p2h_halo(Frame& F) {
    F.fresh();
    const int gt = F.vcu * NTHREADS + F.tid, NGT = F.G * NTHREADS;
    const bf16_t* PROJ = (const bf16_t*)(F.ws + WS_PROJ); bf16_t* HALO = (bf16_t*)(F.ws + WS_HALO);
    constexpr int NCH16 = 3072 / 8;
    for (int i = gt; i < NBATCH * NCHUNK * 3 * NCH16; i += NGT) {
        const int cc = i % NCH16, r = (i / NCH16) % 3, bn = i / (NCH16 * 3), n = bn % NCHUNK, b = bn / NCHUNK;
        u32x4 v = {0u, 0u, 0u, 0u};
        if (n > 0) v = *(const u32x4*)(PROJ + (size_t)(b * SEQ + n * 64 - 3 + r) * P1N + C_Q + cc * 8);
        *(u32x4*)(HALO + ((size_t)bn * 3 + r) * 3072 + cc * 8) = v;
    }
}
__device__ __forceinline__ void p2h_pool(Frame& F) {
    F.fresh();
    const bf16_t* PROJ = (const bf16_t*)(F.ws + WS_PROJ); bf16_t* POOLED = (bf16_t*)(F.ws + WS_POOLED); const bf16_t* PW = (const bf16_t*)(F.ws + WS_POOLW);
    LAS bf16_t* Pm = (LAS bf16_t*)F.lds; LAS bf16_t* Wg = (LAS bf16_t*)(F.lds + 34816);
    const int lane = F.lane, w = F.wave;
    for (int u = F.vcu; u < 512 * 4; u += F.G) {
        const int g = u & 3, tt = u >> 2;
        for (int q = F.tid; q < 2048; q += NTHREADS) { const int row = q >> 4, cc = q & 15; *(LAS u32x4*)(Wg + row * 136 + cc * 8) = *(const u32x4*)(PW + (size_t)g * 16384 + row * 128 + cc * 8); }
        const int win = 2 << g;
        for (int q = F.tid; q < 2048; q += NTHREADS) {
            const int tl = q >> 4, cg = q & 15; const int t = tt * 128 + tl, s = t & (SEQ - 1);
            const int cnt = (s + 1 < win) ? (s + 1) : win;
            float sum[8], cur[8], tmp[8];
            const bf16_t* src = PROJ + (size_t)t * P1N + C_XA + g * 128 + cg * 8;
            unpack8(*(const u32x4*)src, cur);
#pragma unroll
            for (int i = 0; i < 8; ++i) sum[i] = cur[i];
            for (int j = 1; j < cnt; ++j) { unpack8(*(const u32x4*)(src - (size_t)j * P1N), tmp);
#pragma unroll
                for (int i = 0; i < 8; ++i) sum[i] += tmp[i]; }
            const float inv = 1.0f / (float)cnt;
#pragma unroll
            for (int i = 0; i < 8; ++i) sum[i] = sum[i] * inv - cur[i];
            *(LAS u32x4*)(Pm + tl * 136 + cg * 8) = pack8(sum);
        }
        __syncthreads();
        f32x4 acc[8];
#pragma unroll
        for (int mi = 0; mi < 8; ++mi) acc[mi] = (f32x4){0.f, 0.f, 0.f, 0.f};
#pragma unroll
        for (int k0 = 0; k0 < 128; k0 += 32) { const bf16x8 b = ldfrag(Wg, 136, w * 16, k0, lane);
#pragma unroll
            for (int mi = 0; mi < 8; ++mi) acc[mi] = mfma16(ldfrag(Pm, 136, mi * 16, k0, lane), b, acc[mi]); }
        const int dcol = w * 16 + (lane & 15); const float psc = F.pool_scale[g * 128 + dcol];
#pragma unroll
        for (int mi = 0; mi < 8; ++mi)
#pragma unroll
            for (int r = 0; r < 4; ++r) { const int row = mi * 16 + (lane >> 4) * 4 + r; POOLED[(size_t)(tt * 128 + row) * 512 + g * 128 + dcol] = f2bf(acc[mi][r] * psc); }
        __syncthreads();
    }
}

__device__ __forceinline__ void conv_silu8(const u32x4 r0, const u32x4 r1, const u32x4 r2, const u32x4 r3, const float (&wj)[4][8], float* sv) {
    float x0[8], x1[8], x2[8], x3[8]; unpack8(r0, x0); unpack8(r1, x1); unpack8(r2, x2); unpack8(r3, x3);
#pragma unroll
    for (int i = 0; i < 8; ++i) { const float y = (wj[0][i] * x0[i] + wj[1][i] * x1[i]) + (wj[2][i] * x2[i] + wj[3][i] * x3[i]); sv[i] = y / (1.0f + __expf(-y)); }
}
constexpr int P2_QN = 0, P2_KN = 17408, P2_VBT = 34816, P2_KBGT = 53248, P2_LM = 71680  , P2_TB = 89088  , P2_SCAL = 98304  , P2_PART = 98816  , P2_TF = 107008  ;
__device__ __forceinline__ void p2_chunk_prep(Frame& F) {
    F.fresh();
    bf16_t* PROJ = (bf16_t*)(F.ws + WS_PROJ); const bf16_t* HALO = (const bf16_t*)(F.ws + WS_HALO); bf16_t* WBUF = (bf16_t*)(F.ws + WS_WBUF); bf16_t* ABUF = (bf16_t*)(F.ws + WS_ABUF);
    const float* BETA = (const float*)(F.ws + WS_BETA); const float* GRAW = (const float*)(F.ws + WS_GRAW); float* GC = (float*)(F.ws + WS_GC);
    LAS bf16_t* QN = (LAS bf16_t*)(F.lds + P2_QN); LAS bf16_t* KN = (LAS bf16_t*)(F.lds + P2_KN); LAS bf16_t* VBT = (LAS bf16_t*)(F.lds + P2_VBT); LAS bf16_t* KBGT = (LAS bf16_t*)(F.lds + P2_KBGT);
    LAS float* LM = (LAS float*)(F.lds + P2_LM); LAS bf16_t* TB = (LAS bf16_t*)(F.lds + P2_TB); LAS float* SBETA = (LAS float*)(F.lds + P2_SCAL); LAS float* SGC = SBETA + 64; LAS float* PART = (LAS float*)(F.lds + P2_PART); LAS float* TF = (LAS float*)(F.lds + P2_TF);
    const int tid = F.tid, lane = F.lane, w = F.wave;
    const float scale = 0.08838834764831845f;
    for (int u = F.vcu; u < NBATCH * NCHUNK * 8; u += F.G) {
        const int h = u & 7, bn = u >> 3, n = bn % NCHUNK, b = bn / NCHUNK; const int t0 = b * SEQ + n * 64;
        if (w == 0) {
            const float be = BETA[(size_t)(t0 + lane) * 8 + h]; float g = GRAW[(size_t)(t0 + lane) * 8 + h];
#pragma unroll
            for (int o = 1; o < 64; o <<= 1) { const float up = __shfl_up(g, o); if (lane >= o) g += up; }
            SBETA[lane] = be; SGC[lane] = g; GC[(size_t)(t0 + lane) * 8 + h] = g;
        }
        const int cgI = tid % 48, run = tid / 48;
        const int typ = cgI >> 4, cc = cgI & 15; const int col = C_Q + typ * 1024 + h * 128 + cc * 8;
        u32x4 raw[11];
        if (tid < 384) {
#pragma unroll
            for (int rr = 0; rr < 11; ++rr) { const int tl = 8 * run - 3 + rr;
                if (tl >= 0) raw[rr] = *(const u32x4*)(PROJ + (size_t)(t0 + tl) * P1N + col);
                else raw[rr] = *(const u32x4*)(HALO + ((size_t)bn * 3 + (tl + 3)) * 3072 + (col - C_Q)); }
        }
        VM_WAIT();
        __syncthreads();
        float wj[4][8];
        if (tid < 384) {
#pragma unroll
            for (int j = 0; j < 4; ++j) { const f32x4 a = *(const f32x4*)(F.conv_w + (size_t)j * 3072 + (col - C_Q)), bq = *(const f32x4*)(F.conv_w + (size_t)j * 3072 + (col - C_Q) + 4);
                wj[j][0] = a[0]; wj[j][1] = a[1]; wj[j][2] = a[2]; wj[j][3] = a[3]; wj[j][4] = bq[0]; wj[j][5] = bq[1]; wj[j][6] = bq[2]; wj[j][7] = bq[3]; }
            if (typ < 2) {
#pragma unroll
                for (int tok = 0; tok < 8; ++tok) { float sv[8]; conv_silu8(raw[tok], raw[tok + 1], raw[tok + 2], raw[tok + 3], wj, sv);
                    float ps = 0.f;
#pragma unroll
                    for (int i = 0; i < 8; ++i) ps += sv[i] * sv[i];
                    PART[(8 * run + tok) * 32 + cgI] = ps; __builtin_amdgcn_sched_barrier(0); }
            }
        }
        __syncthreads();
        if (tid < 384) {
            const float gl = SGC[63];
#pragma unroll
            for (int tok = 0; tok < 8; ++tok) {
                float sv[8]; conv_silu8(raw[tok], raw[tok + 1], raw[tok + 2], raw[tok + 3], wj, sv);
                const int tg = 8 * run + tok; const float be = SBETA[tg], gc = SGC[tg]; const float eg = __expf(gc);
                if (typ < 2) {
                    float tot = 0.f;
#pragma unroll
                    for (int c4 = 0; c4 < 4; ++c4) { const f32x4 p = *(const LAS f32x4*)(PART + tg * 32 + typ * 16 + c4 * 4); tot += (p[0] + p[1]) + (p[2] + p[3]); }
                    const float rn = 1.0f / sqrtf(tot + EPS);
                    float nv[8], ov[8];
#pragma unroll
                    for (int i = 0; i < 8; ++i) nv[i] = sv[i] * rn;
                    if (typ == 0) {
                        *(LAS u32x4*)(QN + tg * 136 + cc * 8) = pack8(nv);
                        const float f = scale * eg;
#pragma unroll
                        for (int i = 0; i < 8; ++i) ov[i] = nv[i] * f;
                        *(u32x4*)(PROJ + (size_t)(t0 + tg) * P1N + col) = pack8(ov);
                    } else {
                        *(LAS u32x4*)(KN + tg * 136 + cc * 8) = pack8(nv);
                        const float f = __expf(gl - gc), f2 = be * eg;
#pragma unroll
                        for (int i = 0; i < 8; ++i) { ov[i] = nv[i] * f; KBGT[(cc * 8 + i) * 72 + tg] = f2bf(nv[i] * f2); }
                        *(u32x4*)(PROJ + (size_t)(t0 + tg) * P1N + col) = pack8(ov);
                    }
                } else {
#pragma unroll
                    for (int i = 0; i < 8; ++i) VBT[(cc * 8 + i) * 72 + tg] = f2bf(sv[i] * be);
                }
                __builtin_amdgcn_sched_barrier(0);
            }
        }
        __syncthreads();
        {
            const int mi = w & 3; const bool isq = w >= 4;
            f32x4 acc[4];
#pragma unroll
            for (int ni = 0; ni < 4; ++ni) acc[ni] = (f32x4){0.f, 0.f, 0.f, 0.f};
#pragma unroll
            for (int k0 = 0; k0 < 128; k0 += 32) { const bf16x8 a = ldfrag(isq ? QN : KN, 136, mi * 16, k0, lane);
#pragma unroll
                for (int ni = 0; ni < 4; ++ni) acc[ni] = mfma16(a, ldfrag(KN, 136, ni * 16, k0, lane), acc[ni]); }
#pragma unroll
            for (int ni = 0; ni < 4; ++ni)
#pragma unroll
                for (int r = 0; r < 4; ++r) { const int i = mi * 16 + (lane >> 4) * 4 + r, j = ni * 16 + (lane & 15);
                    const float dec = __expf(fminf(SGC[i] - SGC[j], 0.f));
                    if (!isq) LM[i * 68 + j] = (i > j) ? SBETA[i] * acc[ni][r] * dec : 0.f;
                    else ABUF[(size_t)u * 4096 + i * 64 + j] = f2bf((i >= j) ? acc[ni][r] * scale * dec : 0.f); }
        }
        __syncthreads();
        if (w == 0) {
            for (int i = 0; i < 64; ++i) {
                float s0 = (i == lane) ? 1.f : 0.f, s1 = 0.f, s2 = 0.f, s3 = 0.f;
                const LAS float* lr = LM + i * 68;
                int j = 0;
                for (; j + 4 <= i; j += 4) { const f32x4 l4 = *(const LAS f32x4*)(lr + j);
                    s0 -= l4[0] * TF[(j + 0) * 65 + lane]; s1 -= l4[1] * TF[(j + 1) * 65 + lane]; s2 -= l4[2] * TF[(j + 2) * 65 + lane]; s3 -= l4[3] * TF[(j + 3) * 65 + lane]; }
                for (; j < i; ++j) s0 -= lr[j] * TF[j * 65 + lane];
                const float s = (s0 + s1) + (s2 + s3);
                TF[i * 65 + lane] = s;
                TB[i * 72 + lane] = f2bf(s);
            }
        }
        __syncthreads();
        {
            f32x4 au[4], aw[4];
#pragma unroll
            for (int mi = 0; mi < 4; ++mi) { au[mi] = (f32x4){0.f, 0.f, 0.f, 0.f}; aw[mi] = (f32x4){0.f, 0.f, 0.f, 0.f}; }
#pragma unroll
            for (int k0 = 0; k0 < 64; k0 += 32) { const bf16x8 bv = ldfrag(VBT, 72, w * 16, k0, lane), bk = ldfrag(KBGT, 72, w * 16, k0, lane);
#pragma unroll
                for (int mi = 0; mi < 4; ++mi) { const bf16x8 a = ldfrag(TB, 72, mi * 16, k0, lane); au[mi] = mfma16(a, bv, au[mi]); aw[mi] = mfma16(a, bk, aw[mi]); } }
            const int cl = w * 16 + (lane & 15);
#pragma unroll
            for (int mi = 0; mi < 4; ++mi)
#pragma unroll
                for (int r = 0; r < 4; ++r) { const int i = mi * 16 + (lane >> 4) * 4 + r;
                    PROJ[(size_t)(t0 + i) * P1N + C_V + h * 128 + cl] = f2bf(au[mi][r]);
                    WBUF[(size_t)(t0 + i) * DM + h * 128 + cl] = f2bf(aw[mi][r]); }
        }
        __syncthreads();
    }
}

constexpr int P3_WC = 0, P3_QGC = 17408, P3_KDT = 34816, P3_AC = 53248, P3_SBT = 62464, P3_VNT = 71168, P3_UC = 75776;
__device__ __forceinline__ void p3_scan(Frame& F) {
    F.fresh();
    bf16_t* PROJ = (bf16_t*)(F.ws + WS_PROJ); const bf16_t* WBUF = (const bf16_t*)(F.ws + WS_WBUF); const bf16_t* ABUF = (const bf16_t*)(F.ws + WS_ABUF); const float* GC = (const float*)(F.ws + WS_GC);
    LAS bf16_t* WC = (LAS bf16_t*)(F.lds + P3_WC); LAS bf16_t* QGC = (LAS bf16_t*)(F.lds + P3_QGC); LAS bf16_t* KDT = (LAS bf16_t*)(F.lds + P3_KDT); LAS bf16_t* AC = (LAS bf16_t*)(F.lds + P3_AC);
    LAS bf16_t* SBT = (LAS bf16_t*)(F.lds + P3_SBT); LAS bf16_t* VNT = (LAS bf16_t*)(F.lds + P3_VNT); LAS bf16_t* UC = (LAS bf16_t*)(F.lds + P3_UC);
    const int tid = F.tid, lane = F.lane, w = F.wave;
    for (int u = F.vcu; u < NBATCH * 8 * 4; u += F.G) {
        const int sl = u & 3, h = (u >> 2) & 7, b = u >> 5;
        for (int i = tid; i < 32 * 136; i += NTHREADS) SBT[i] = 0;
        f32x4 accS[2]; accS[0] = (f32x4){0.f, 0.f, 0.f, 0.f}; accS[1] = (f32x4){0.f, 0.f, 0.f, 0.f};
        const int r0 = tid >> 4, c0 = tid & 15;
        const int ra = tid >> 3, ca = tid & 7;
        const int ru = (tid & 255) >> 2, cu = tid & 3;
        u32x4 pw[2], pq[2], pk[2], pa, pu; float pgl;
#define P3_LOAD(nn) do { const size_t tt0 = (size_t)b * SEQ + (size_t)(nn) * 64; \
            _Pragma("unroll") for (int k = 0; k < 2; ++k) { const size_t row = tt0 + r0 + 32 * k; \
                pw[k] = *(const u32x4*)(WBUF + row * DM + h * 128 + c0 * 8); pq[k] = *(const u32x4*)(PROJ + row * P1N + C_Q + h * 128 + c0 * 8); pk[k] = *(const u32x4*)(PROJ + row * P1N + C_K + h * 128 + c0 * 8); } \
            pa = *(const u32x4*)(ABUF + ((size_t)(b * NCHUNK + (nn)) * 8 + h) * 4096 + ra * 64 + ca * 8); \
            if (tid < 256) pu = *(const u32x4*)(PROJ + (tt0 + ru) * P1N + C_V + h * 128 + sl * 32 + cu * 8); \
            pgl = GC[(tt0 + 63) * 8 + h]; } while (0)
        P3_LOAD(0);
        for (int n = 0; n < NCHUNK; ++n) {
            const size_t t0 = (size_t)b * SEQ + (size_t)n * 64;
#pragma unroll
            for (int k = 0; k < 2; ++k) { const int row = r0 + 32 * k;
                *(LAS u32x4*)(WC + row * 136 + c0 * 8) = pw[k]; *(LAS u32x4*)(QGC + row * 136 + c0 * 8) = pq[k];
                const unsigned kw[4] = {pk[k].x, pk[k].y, pk[k].z, pk[k].w};
#pragma unroll
                for (int i = 0; i < 4; ++i) { KDT[(c0 * 8 + 2 * i) * 72 + row] = (bf16_t)(kw[i] & 0xffffu); KDT[(c0 * 8 + 2 * i + 1) * 72 + row] = (bf16_t)(kw[i] >> 16); } }
            *(LAS u32x4*)(AC + ra * 72 + ca * 8) = pa;
            if (tid < 256) *(LAS u32x4*)(UC + ru * 40 + cu * 8) = pu;
            const float egl = __expf(pgl);
            __syncthreads();
            if (n + 1 < NCHUNK) P3_LOAD(n + 1);
            const int mi = w >> 1, ni = w & 1;
            f32x4 ax = (f32x4){0.f, 0.f, 0.f, 0.f}, ay = (f32x4){0.f, 0.f, 0.f, 0.f};
#pragma unroll
            for (int k0 = 0; k0 < 128; k0 += 32) { const bf16x8 bs = ldfrag(SBT, 136, ni * 16, k0, lane);
                ax = mfma16(ldfrag(WC, 136, mi * 16, k0, lane), bs, ax); ay = mfma16(ldfrag(QGC, 136, mi * 16, k0, lane), bs, ay); }
            const int e = ni * 16 + (lane & 15);
#pragma unroll
            for (int r = 0; r < 4; ++r) { const int i = mi * 16 + (lane >> 4) * 4 + r; VNT[e * 72 + i] = f2bf(bf2f(UC[i * 40 + e]) - ax[r]); }
            __syncthreads();
#pragma unroll
            for (int k0 = 0; k0 < 64; k0 += 32) ay = mfma16(ldfrag(AC, 72, mi * 16, k0, lane), ldfrag(VNT, 72, ni * 16, k0, lane), ay);
#pragma unroll
            for (int r = 0; r < 4; ++r) { const int i = mi * 16 + (lane >> 4) * 4 + r; PROJ[(t0 + i) * P1N + C_V + h * 128 + sl * 32 + e] = f2bf(ay[r]); }
#pragma unroll
            for (int mt = 0; mt < 2; ++mt) { accS[mt] = accS[mt] * egl;
#pragma unroll
                for (int k0 = 0; k0 < 64; k0 += 32) accS[mt] = mfma16(ldfrag(VNT, 72, mt * 16, k0, lane), ldfrag(KDT, 72, w * 16, k0, lane), accS[mt]);
#pragma unroll
                for (int r = 0; r < 4; ++r) SBT[(mt * 16 + (lane >> 4) * 4 + r) * 136 + w * 16 + (lane & 15)] = f2bf(accS[mt][r]); }
            __syncthreads();
        }
#undef P3_LOAD
    }
}

__device__ __forceinline__ void p4_gated_norm(Frame& F) {
    F.fresh();
    bf16_t* PROJ = (bf16_t*)(F.ws + WS_PROJ);
    const int gt = F.vcu * NTHREADS + F.tid, NGT = F.G * NTHREADS;
    const int sub = F.lane & 15;
    float nw[8];
    { const f32x4 a = *(const f32x4*)(F.dn_norm_w + sub * 8), bq = *(const f32x4*)(F.dn_norm_w + sub * 8 + 4); nw[0] = a[0]; nw[1] = a[1]; nw[2] = a[2]; nw[3] = a[3]; nw[4] = bq[0]; nw[5] = bq[1]; nw[6] = bq[2]; nw[7] = bq[3]; }
    for (int i = gt; i < NTOK * 8 * 16; i += NGT) {
        const int th = i >> 4; const int t = th >> 3, h = th & 7;
        bf16_t* po = PROJ + (size_t)t * P1N + C_V + h * 128 + sub * 8; const bf16_t* pz = PROJ + (size_t)t * P1N + C_Z + h * 128 + sub * 8;
        float o[8], z[8]; unpack8(*(const u32x4*)po, o); unpack8(*(const u32x4*)pz, z);
        float s = 0.f;
#pragma unroll
        for (int k = 0; k < 8; ++k) s += o[k] * o[k];
        s += __shfl_xor(s, 1); s += __shfl_xor(s, 2); s += __shfl_xor(s, 4); s += __shfl_xor(s, 8);
        const float rstd = 1.0f / sqrtf(s * (1.f / 128.f) + EPS);
#pragma unroll
        for (int k = 0; k < 8; ++k) { const float zz = z[k]; o[k] = o[k] * rstd * nw[k] * (zz / (1.0f + __expf(-zz))); }
        *(u32x4*)po = pack8(o);
    }
}

constexpr int P10_QS = 0  , P10_KS = 17408  , P10_SC = 52224  , P10_LST = 118016  ;
__device__ __forceinline__ void bubble16(float (&v)[16], int (&ix)[16], float x, int id) {
    if (x > v[15]) { v[15] = x; ix[15] = id;
#pragma unroll
        for (int q = 15; q >= 1; --q) { const bool sw = v[q] > v[q - 1]; const float a = v[q], bq = v[q - 1]; const int ia = ix[q], ib = ix[q - 1];
            v[q] = sw ? bq : a; v[q - 1] = sw ? a : bq; ix[q] = sw ? ib : ia; ix[q - 1] = sw ? ia : ib; } }
}
__device__ __forceinline__ void p10_topk(Frame& F) {
    F.fresh();
    const bf16_t* Q2 = (const bf16_t*)(F.ws + WS_Q2); const bf16_t* KEYS = (const bf16_t*)(F.ws + WS_KEYS); int* IDX = (int*)(F.ws + WS_IDX); float* GATEW = (float*)(F.ws + WS_GATEW);
    LAS bf16_t* QS = (LAS bf16_t*)(F.lds + P10_QS); LAS bf16_t* KS = (LAS bf16_t*)(F.lds + P10_KS); LAS float* SC = (LAS float*)(F.lds + P10_SC);
    LAS float* LV = (LAS float*)(F.lds + P10_LST); LAS int* LI = (LAS int*)(F.lds + P10_LST + 8192);
    const int tid = F.tid, lane = F.lane, w = F.wave;
    for (int u = F.vcu; u < (NTOK / 64) * 8; u += F.G) {
        const int h = u & 7, tt = u >> 3; const int t0 = tt * 64;
        for (int p = 0; p < 2; ++p) {
            for (int q = tid; q < 1024; q += NTHREADS) { const int row = q >> 4, cc = q & 15; *(LAS u32x4*)(QS + row * 136 + cc * 8) = *(const u32x4*)(Q2 + (size_t)(t0 + row) * 2048 + h * 256 + p * 128 + cc * 8); }
            for (int q = tid; q < 2048; q += NTHREADS) { const int row = q >> 4, cc = q & 15; *(LAS u32x4*)(KS + row * 136 + cc * 8) = *(const u32x4*)(KEYS + (size_t)(h * 2 + p) * 16384 + row * 128 + cc * 8); }
            __syncthreads();
            f32x4 acc[4];
#pragma unroll
            for (int mi = 0; mi < 4; ++mi) acc[mi] = (f32x4){0.f, 0.f, 0.f, 0.f};
#pragma unroll
            for (int k0 = 0; k0 < 128; k0 += 32) { const bf16x8 bk = ldfrag(KS, 136, w * 16, k0, lane);
#pragma unroll
                for (int mi = 0; mi < 4; ++mi) acc[mi] = mfma16(ldfrag(QS, 136, mi * 16, k0, lane), bk, acc[mi]); }
#pragma unroll
            for (int mi = 0; mi < 4; ++mi)
#pragma unroll
                for (int r = 0; r < 4; ++r) SC[(mi * 16 + (lane >> 4) * 4 + r) * 257 + p * 128 + w * 16 + (lane & 15)] = acc[mi][r];
            __syncthreads();
        }
        if (tid < 128) {
            const int tk = tid & 63, p = tid >> 6;
            float v[16]; int ix[16];
#pragma unroll
            for (int q = 0; q < 16; ++q) { v[q] = -3.0e38f; ix[q] = 0; }
            const LAS float* src = SC + tk * 257 + p * 128;
            for (int e = 0; e < 128; ++e) bubble16(v, ix, src[e], e);
#pragma unroll
            for (int q = 0; q < 16; ++q) { LV[(tk * 2 + p) * 16 + q] = v[q]; LI[(tk * 2 + p) * 16 + q] = ix[q]; }
        }
        __syncthreads();
        if (tid < 64) {
            const int tk = tid;
            float v1[16], v2[16]; int i1[16], i2[16];
#pragma unroll
            for (int q = 0; q < 16; ++q) { v1[q] = LV[(tk * 2) * 16 + q]; v2[q] = LV[(tk * 2 + 1) * 16 + q]; i1[q] = LI[(tk * 2) * 16 + q]; i2[q] = LI[(tk * 2 + 1) * 16 + q]; }
            float v[16]; int ix[16];
#pragma unroll
            for (int q = 0; q < 16; ++q) { v[q] = -3.0e38f; ix[q] = 0; }
#pragma unroll
            for (int i = 0; i < 16; ++i)
#pragma unroll
                for (int j = 0; j < 16 / (i + 1); ++j) bubble16(v, ix, v1[i] + v2[j], i1[i] * 128 + i2[j]);
            float ex[16], sum = 0.f;
#pragma unroll
            for (int q = 0; q < 16; ++q) { ex[q] = __expf(v[q] - v[0]); sum += ex[q]; }
            const float inv = 1.0f / sum;
            int* pi = IDX + (size_t)(t0 + tk) * 128 + h * 16; float* pg = GATEW + (size_t)(t0 + tk) * 128 + h * 16;
#pragma unroll
            for (int q = 0; q < 16; ++q) { pi[q] = ix[q]; pg[q] = ex[q] * inv; }
        }
        __syncthreads();
    }
}

template <int HALFK> __device__ __forceinline__ void p11_down(const bf16_t* ED, int ev, float gv, const float (&hf)[16], float rstd, int lane, float& cv) {
#pragma unroll 4
    for (int k = 0; k < 64; ++k) {
        const int e = __builtin_amdgcn_readlane(ev, k);
        const u32x4 d0 = *(const u32x4*)(ED + (size_t)e * 1024 + lane * 8), d1 = *(const u32x4*)(ED + (size_t)e * 1024 + 512 + lane * 8);
        float f0[8], f1[8]; unpack8(d0, f0); unpack8(d1, f1);
        float dot = 0.f;
#pragma unroll
        for (int i = 0; i < 8; ++i) dot += hf[i] * f0[i] + hf[8 + i] * f1[i];
        dot = wave_sum(dot);
        const float a = rstd * dot; const float act = 0.5f * a * (1.0f + erff(a * 0.70710678118654752f));
        const float gk = __shfl(gv, k);
        cv = (lane == k) ? act * gk : cv;
    }
}
__device__ __forceinline__ void p11_up(const bf16_t* EU, int ev, float cv, float (&y)[16], int lane) {
#pragma unroll 4
    for (int k = 0; k < 64; ++k) {
        const int e = __builtin_amdgcn_readlane(ev, k); const float c = __shfl(cv, k);
        const u32x4 d0 = *(const u32x4*)(EU + (size_t)e * 1024 + lane * 8), d1 = *(const u32x4*)(EU + (size_t)e * 1024 + 512 + lane * 8);
        float f0[8], f1[8]; unpack8(d0, f0); unpack8(d1, f1);
#pragma unroll
        for (int i = 0; i < 8; ++i) { y[i] += c * f0[i]; y[8 + i] += c * f1[i]; }
    }
}
__device__ __forceinline__ void p11_peer(Frame& F) {
    F.fresh();
    const bf16_t* HB = (const bf16_t*)(F.ws + WS_WBUF); const float* SSQ = (const float*)(F.ws + WS_SSQ); const int* IDX = (const int*)(F.ws + WS_IDX); const float* GATEW = (const float*)(F.ws + WS_GATEW);
    const bf16_t* ED = (const bf16_t*)(F.ws + WS_EDOWN); const bf16_t* EU = (const bf16_t*)(F.ws + WS_EUP);
    const int gw = F.vcu * NWAVES + F.wave, NGW = F.G * NWAVES, lane = F.lane;
    float fw[16];
#pragma unroll
    for (int q = 0; q < 4; ++q) { const f32x4 a = *(const f32x4*)(F.final_norm_w + (q >> 1) * 512 + lane * 8 + (q & 1) * 4); fw[q * 4 + 0] = a[0]; fw[q * 4 + 1] = a[1]; fw[q * 4 + 2] = a[2]; fw[q * 4 + 3] = a[3]; }
    for (int t = gw; t < NTOK; t += NGW) {
        const int e0 = IDX[(size_t)t * 128 + lane], e1 = IDX[(size_t)t * 128 + 64 + lane];
        const float g0 = GATEW[(size_t)t * 128 + lane], g1 = GATEW[(size_t)t * 128 + 64 + lane];
        float hf[16];
        { float a[8], bq[8]; unpack8(*(const u32x4*)(HB + (size_t)t * DM + lane * 8), a); unpack8(*(const u32x4*)(HB + (size_t)t * DM + 512 + lane * 8), bq);
#pragma unroll
            for (int i = 0; i < 8; ++i) { hf[i] = a[i]; hf[8 + i] = bq[i]; } }
        float rstd; { const f32x4* sp = (const f32x4*)(SSQ + (size_t)t * 16); const f32x4 s4 = (sp[0] + sp[1]) + (sp[2] + sp[3]); rstd = 1.0f / sqrtf(((s4[0] + s4[1]) + (s4[2] + s4[3])) * (1.f / DM) + EPS); }
        float c0 = 0.f, c1 = 0.f;
        p11_down<0>(ED, e0, g0, hf, rstd, lane, c0);
        p11_down<1>(ED, e1, g1, hf, rstd, lane, c1);
        float y[16];
#pragma unroll
        for (int i = 0; i < 16; ++i) y[i] = 0.f;
        p11_up(EU, e0, c0, y, lane);
        p11_up(EU, e1, c1, y, lane);
        float* hrow = F.out + (size_t)t * DM;
        float z[16]; float ss = 0.f;
#pragma unroll
        for (int q = 0; q < 4; ++q) { const f32x4 a = *(const f32x4*)(hrow + (q >> 1) * 512 + lane * 8 + (q & 1) * 4);
#pragma unroll
            for (int i = 0; i < 4; ++i) { const float zz = a[i] + y[q * 4 + i]; z[q * 4 + i] = zz; ss += zz * zz; } }
        const float r2 = 1.0f / sqrtf(wave_sum(ss) * (1.f / DM) + EPS);
#pragma unroll
        for (int q = 0; q < 4; ++q) { f32x4 o;
#pragma unroll
            for (int i = 0; i < 4; ++i) o[i] = z[q * 4 + i] * r2 * fw[q * 4 + i];
            *(f32x4*)(hrow + (q >> 1) * 512 + lane * 8 + (q & 1) * 4) = o; }
    }
}

static __device__ __forceinline__ void grid_barrier(cg::grid_group& grid) {
    asm volatile("s_waitcnt vmcnt(0) lgkmcnt(0)" ::: "memory");
    __syncthreads();
    if (threadIdx.x == 0) { __builtin_amdgcn_fence(__ATOMIC_RELEASE, "agent"); asm volatile("s_waitcnt vmcnt(0)" ::: "memory"); }
    grid.sync();
    if (threadIdx.x == 0) { __builtin_amdgcn_fence(__ATOMIC_ACQUIRE, "agent"); asm volatile("s_waitcnt vmcnt(0)" ::: "memory"); }
    __syncthreads();
}

#ifdef DUMP_AFTER
static __device__ __forceinline__ void dbg_dump(Frame& F, int mode) {
    const size_t gt = (size_t)F.vcu * NTHREADS + F.tid, NGT = (size_t)F.G * NTHREADS;
    const bf16_t* PROJ = (const bf16_t*)(F.ws + WS_PROJ); const bf16_t* WBUF = (const bf16_t*)(F.ws + WS_WBUF); const bf16_t* ABUF = (const bf16_t*)(F.ws + WS_ABUF);
    const bf16_t* POOLED = (const bf16_t*)(F.ws + WS_POOLED); const float* GC = (const float*)(F.ws + WS_GC); const bf16_t* Q2 = (const bf16_t*)(F.ws + WS_Q2);
    const int* IDX = (const int*)(F.ws + WS_IDX); const float* GATEW = (const float*)(F.ws + WS_GATEW);
    for (size_t i = gt; i < (size_t)NTOK * DM; i += NGT) {
        const size_t t = i >> 10; const int cidx = (int)(i & 1023);
        float v = 0.f;
        if (mode == 1 || mode == 3) { const bf16_t* r = PROJ + t * P1N; v = bf2f(r[cidx]) + bf2f(r[1024 + cidx]) + bf2f(r[2048 + cidx]) + bf2f(r[3072 + cidx]) + bf2f(r[3584 + cidx]); }
        if (mode == 2) v = bf2f(POOLED[t * 512 + (cidx & 511)]);
        if (mode == 3) v += bf2f(WBUF[t * DM + cidx]) + bf2f(ABUF[(t >> 6) * 8 * 4096 + (size_t)(cidx >> 7) * 4096 + (t & 63) * 64 + (cidx & 63)]) + GC[t * 8 + (cidx & 7)];
        if (mode == 4 || mode == 5) v = bf2f(PROJ[t * P1N + C_V + cidx]);
        if (mode == 6 || mode == 7) v = bf2f(ABUF[t * DM + cidx]);
        if (mode == 9) v = bf2f(Q2[t * 2048 + cidx]) + bf2f(Q2[t * 2048 + 1024 + cidx]);
        if (mode == 10) v = (float)IDX[t * 128 + (cidx & 127)] * 1e-3f + GATEW[t * 128 + (cidx & 127)];
        F.out[i] = v;
    }
}
#define DUMP(k) do { if (DUMP_AFTER == (k)) { if ((k) != 8) dbg_dump(F, (k)); return; } } while (0)
#else
#define DUMP(k) do {} while (0)
#endif
#ifndef PHM
#define PHM 0x1fff
#endif
__global__ void __launch_bounds__(NTHREADS, 2) hybrid_fwd(Params p) {
    extern __shared__ __attribute__((aligned(16))) unsigned char lds_raw[];
    cg::grid_group grid = cg::this_grid();
    Frame F;
    F.lds = (LAS unsigned char*)lds_raw;
    F.tid = threadIdx.x; F.lane = F.tid & 63; F.wave = __builtin_amdgcn_readfirstlane(F.tid >> 6);
    F.G = gridDim.x; { const int bx = blockIdx.x; F.vcu = (F.G % 8 == 0) ? (bx % 8) * (F.G / 8) + bx / 8 : bx; }
    F.x = p.in[0]; F.mix_norm_w = p.in[1]; F.w_in = p.in[2]; F.pool_w = p.in[3]; F.pool_scale = p.in[4]; F.conv_w = p.in[5]; F.a_log = p.in[6]; F.dt_bias = p.in[7]; F.dn_norm_w = p.in[8];
    F.w_pool_up = p.in[9]; F.w_dn_up = p.in[10]; F.w_mix_out = p.in[11]; F.ffn_norm_w = p.in[12]; F.w_query = p.in[13]; F.keys1 = p.in[14]; F.keys2 = p.in[15]; F.peer_down = p.in[16]; F.peer_up = p.in[17]; F.final_norm_w = p.in[18];
    F.out = p.out; F.ws = p.ws;
    unsigned char* ws = p.ws;
    bf16_t* XN = (bf16_t*)p.out; bf16_t* GB = (bf16_t*)((unsigned char*)p.out + 128 * MiB);
    bf16_t* PROJ = (bf16_t*)(ws + WS_PROJ); bf16_t* WIN = (bf16_t*)(ws + WS_WIN);
    bf16_t* GA = (bf16_t*)(ws + WS_WBUF); bf16_t* MERGED = (bf16_t*)(ws + WS_ABUF); bf16_t* HBp = (bf16_t*)(ws + WS_WBUF);

#ifdef ZERO_FILL
    {
        const size_t gt = (size_t)F.vcu * NTHREADS + F.tid, NGT = (size_t)F.G * NTHREADS;
        u32x4 z = {0u, 0u, 0u, 0u};
        u32x4* w4 = (u32x4*)ws; for (size_t i = gt; i < WS_END / 16; i += NGT) w4[i] = z;
        u32x4* o4 = (u32x4*)p.out; for (size_t i = gt; i < (size_t)NTOK * DM * 4 / 16; i += NGT) o4[i] = z;
    }
    grid_barrier(grid);
#endif
#if (PHM >> 0) & 1
    p0_prologue(F);
#endif
    grid_barrier(grid);
#if (PHM >> 1) & 1
    {
        pg8::Gemm g{XN, WIN, NTOK, P1N, DM, DM, DM}; pg8::StaticOrder S; S.init(NTOK, P1N, F.G, (int)blockIdx.x);
        pg8::EpiStore<0> E{PROJ, nullptr, P1N, 0};
        pg8::gemm_phase<pg8::EpiStore<0>, pg8::StaticOrder, true, true>(F.lds, g, S, E);
    }
#endif
    grid_barrier(grid);
    DUMP(1);
#if (PHM >> 2) & 1
    p2h_halo(F);
    p2h_pool(F);
#endif
    grid_barrier(grid);
    DUMP(2);
#if (PHM >> 3) & 1
    p2_chunk_prep(F);
#endif
    grid_barrier(grid);
    DUMP(3);
#if (PHM >> 4) & 1
    p3_scan(F);
#endif
    grid_barrier(grid);
    DUMP(4);
#if (PHM >> 5) & 1
    p4_gated_norm(F);
#endif
#if (PHM >> 6) & 1
    {
        pg8::Gemm g{XN, WIN + (size_t)P1N * DM, NTOK, 2048, DM, DM, DM}; pg8::StaticOrder S; S.init(NTOK, 2048, F.G, (int)blockIdx.x);
        pg8::EpiStore<1> E{GA, GB, DM, 1024};
        pg8::gemm_phase<pg8::EpiStore<1>, pg8::StaticOrder, true, true>(F.lds, g, S, E);
    }
#endif
    grid_barrier(grid);
    DUMP(5);
#if (PHM >> 7) & 1
    {
        pg8::Gemm g{(const bf16_t*)(ws + WS_POOLED), (const bf16_t*)(ws + WS_WPU), NTOK, DM, 512, 512, 512}; pg8::StaticOrder S; S.init(NTOK, DM, F.G, (int)blockIdx.x);
        pg8::EpiGateMul<false> E{MERGED, GA, DM};
        pg8::gemm_phase<pg8::EpiGateMul<false>, pg8::StaticOrder, true, true>(F.lds, g, S, E);
    }
#endif
    grid_barrier(grid);
    DUMP(6);
#if (PHM >> 8) & 1
    {
        pg8::Gemm g{PROJ + C_V, (const bf16_t*)(ws + WS_WDU), NTOK, DM, DM, P1N, DM}; pg8::StaticOrder S; S.init(NTOK, DM, F.G, (int)blockIdx.x);
        pg8::EpiGateMul<true> E{MERGED, GB, DM};
        pg8::gemm_phase<pg8::EpiGateMul<true>, pg8::StaticOrder, true, true>(F.lds, g, S, E);
    }
#endif
    grid_barrier(grid);
    DUMP(7);
#if (PHM >> 9) & 1
    {
        pg8::Gemm g{MERGED, (const bf16_t*)(ws + WS_WMX), NTOK, DM, DM, DM, DM}; pg8::StaticOrder S; S.init(NTOK, DM, F.G, (int)blockIdx.x);
        pg8::EpiResid E{F.x, p.out, HBp, (float*)(ws + WS_SSQ), DM};
        pg8::gemm_phase<pg8::EpiResid, pg8::StaticOrder, true, true>(F.lds, g, S, E);
    }
#endif
    grid_barrier(grid);
    DUMP(8);
#if (PHM >> 10) & 1
    {
        pg8::Gemm g{HBp, (const bf16_t*)(ws + WS_WQ), NTOK, 2048, DM, DM, DM}; pg8::StaticOrder S; S.init(NTOK, 2048, F.G, (int)blockIdx.x);
        pg8::EpiRowScale E{(bf16_t*)(ws + WS_Q2), (const float*)(ws + WS_SSQ), 2048, 1.0f / DM, EPS};
        pg8::gemm_phase<pg8::EpiRowScale, pg8::StaticOrder, true, true>(F.lds, g, S, E);
    }
#endif
    grid_barrier(grid);
    DUMP(9);
#if (PHM >> 11) & 1
    p10_topk(F);
#endif
    grid_barrier(grid);
    DUMP(10);
#if (PHM >> 12) & 1
    p11_peer(F);
#endif
}

extern "C" void kernel_launch(void* const* d_in, const int* in_sizes, int n_in, void* d_out, int out_size, void* d_ws, size_t ws_size, hipStream_t stream) {
    static int grid = 0;
    if (grid == 0) {
        if (n_in != 19 || in_sizes[0] != NTOK * DM || out_size != NTOK * DM || ws_size < WS_END) {
            fprintf(stderr, "kernel_launch: unexpected shapes: n_in %d in0 %d out %d ws %zu (need %zu); nothing launched\n", n_in, n_in > 0 ? in_sizes[0] : -1, out_size, ws_size, (size_t)WS_END); grid = -1; return; }
        int dev = 0, cus = 0, per_cu = 0;
        (void)hipGetDevice(&dev); (void)hipDeviceGetAttribute(&cus, hipDeviceAttributeMultiprocessorCount, dev);
        (void)hipFuncSetAttribute((const void*)hybrid_fwd, hipFuncAttributeMaxDynamicSharedMemorySize, LDS_BYTES);
        (void)hipOccupancyMaxActiveBlocksPerMultiprocessor(&per_cu, (const void*)hybrid_fwd, NTHREADS, LDS_BYTES);
        if (per_cu < 1) { fprintf(stderr, "kernel_launch: occupancy query says %d blocks per CU\n", per_cu); per_cu = 1; }
        grid = cus;
    }
    if (grid < 0) return;
    Params p{};
    for (int i = 0; i < 19; ++i) p.in[i] = (const float*)d_in[i];
    p.out = (float*)d_out; p.ws = (unsigned char*)d_ws;
    void* args[] = {&p};
    hipError_t e = hipLaunchCooperativeKernel((const void*)hybrid_fwd, dim3(grid), dim3(NTHREADS), args, LDS_BYTES, stream);
    if (e != hipSuccess) fprintf(stderr, "cooperative launch failed: %s (grid %d)\n", hipGetErrorString(e), grid);
}
```

```cpp
#include <hip/hip_runtime.h>
#include <hip/hip_cooperative_groups.h>
#include <cstdio>
#include <cstdint>
namespace cg = cooperative_groups;
namespace pg8 {
#define PG8_LAS __attribute__((address_space(3)))
typedef unsigned short bf16_t;
typedef short bf16x8 __attribute__((ext_vector_type(8)));
typedef float f32x4 __attribute__((ext_vector_type(4)));
typedef unsigned u32x4 __attribute__((ext_vector_type(4)));
typedef int v4i_t __attribute__((ext_vector_type(4)));
typedef int v8i_t __attribute__((ext_vector_type(8)));
constexpr int BM = 256, BK = 64, HALF = 128, HTB = HALF * BK * 2  , STAGE_BYTES = 8 * HTB, NXCD = 8, WGM = 8;

__host__ __device__ __forceinline__ int lds_byte(int r, int c) { const int st = (r >> 4) * 2 + (c >> 5), rr = r & 15, cc = c & 31, ob = rr * 64 + cc * 2; return st * 1024 + (ob ^ (((ob >> 9) & 1) << 5)); }
__host__ __device__ __forceinline__ void stage_rc(int b, int& R, int& C) { const int st = b / 1024, sb = b % 1024, swz = sb ^ (((sb >> 9) & 1) << 5); R = (st >> 1) * 16 + swz / 64; C = (st & 1) * 32 + (swz % 64) / 2; }
__host__ __device__ __forceinline__ int perm32(int rho) { const int n = rho >> 4, i = rho & 15; return 8 * (i >> 2) + 4 * n + (i & 3); }

struct Unit { int pm, pn; };
struct Gemm { const bf16_t* A; const bf16_t* Bt; int M, N, K, lda, ldb; };

struct StaticOrder {
    int nM, nN, nwg, G, c;
    __host__ __device__ void init(int M, int N, int G_, int c_) { nM = M / BM; nN = N / BM; nwg = nM * nN; G = G_; c = c_; }
    __host__ __device__ bool next(int i, Unit& u) const {
        const long L = (long)i * G + c; if (L >= nwg) return false;
        int wgid = (int)L; { const int q = nwg / NXCD, r = nwg % NXCD, xcd = wgid % NXCD, off = wgid / NXCD; wgid = (xcd < r ? xcd * (q + 1) : r * (q + 1) + (xcd - r) * q) + off; }
        const int nig = WGM * nN, gid = wgid / nig, fm = gid * WGM, gsz = (nM - fm) < WGM ? (nM - fm) : WGM;
        u.pm = fm + ((wgid % nig) % gsz); u.pn = (wgid % nig) / gsz; return true;
    }
    __device__ __forceinline__ void a_ready(const Unit&) const {}
    __device__ __forceinline__ void done(const Unit&) const {}
};

typedef float f32x2_t __attribute__((ext_vector_type(2))); typedef __bf16 bf16x2_t __attribute__((ext_vector_type(2)));
__device__ __forceinline__ unsigned cvt_pk_bf16(float lo, float hi) { const f32x2_t v = {lo, hi}; const bf16x2_t b = __builtin_convertvector(v, bf16x2_t); return __builtin_bit_cast(unsigned, b); }
__device__ __forceinline__ float bf_lo(unsigned w) { return __uint_as_float(w << 16); }
__device__ __forceinline__ float bf_hi(unsigned w) { return __uint_as_float(w & 0xffff0000u); }
__device__ __forceinline__ float sigmoidf_(float x) { return __builtin_amdgcn_rcpf(1.0f + __expf(-x)); }

template <int ACT> struct EpiStore {
    static constexpr bool PERM = true, AFTER_DRAIN = false;
    bf16_t* O; bf16_t* O2; int ldc; int split_cols; bf16_t* halo; float pre;
    __device__ __forceinline__ void operator()(const f32x4 (&acc)[2][2][4][2], const Unit& u, int wr, int wc, int fr, int fq) const {
        const int row0 = u.pm * BM + wr * 64 + fr; int colt = u.pn * BM; bf16_t* base = O;
        if (split_cols && colt >= split_cols) { base = O2; colt -= split_cols; }
        const int col0 = colt + wc * 32 + 8 * fq;
#pragma unroll
        for (int ai = 0; ai < 2; ++ai)
#pragma unroll
            for (int m = 0; m < 4; ++m) { bf16_t* rowp = base + (size_t)(row0 + ai * HALF + m * 16) * ldc + col0;
#pragma unroll
                for (int bj = 0; bj < 2; ++bj) { f32x4 v0 = acc[ai][bj][m][0], v1 = acc[ai][bj][m][1];
                    if (ACT == 1) {
#pragma unroll
                        for (int e = 0; e < 4; ++e) { v0[e] = sigmoidf_(v0[e] * pre); v1[e] = sigmoidf_(v1[e] * pre); } }
                    u32x4 w; w.x = cvt_pk_bf16(v0[0], v0[1]); w.y = cvt_pk_bf16(v0[2], v0[3]); w.z = cvt_pk_bf16(v1[0], v1[1]); w.w = cvt_pk_bf16(v1[2], v1[3]);
                    *(u32x4*)(rowp + bj * HALF) = w;
                    if (ACT == 0 && m == 3) {
                        if (halo && fr >= 13 && u.pn >= 2 && u.pn < 14) { const int row = row0 + ai * HALF + m * 16; const int cn = (row >> 6) + 1;
                            if ((cn & 127) != 0) *(u32x4*)(halo + ((size_t)cn * 3 + (fr - 13)) * 3072 + (col0 + bj * HALF - 512)) = w; } } } }
    }
};
template <bool ADD> struct EpiGateMul {
    static constexpr bool PERM = true, AFTER_DRAIN = false;
    bf16_t* MG; const bf16_t* G; int ld; float pre;
    __device__ __forceinline__ void operator()(const f32x4 (&acc)[2][2][4][2], const Unit& u, int wr, int wc, int fr, int fq) const {
        const int row0 = u.pm * BM + wr * 64 + fr; const int col0 = u.pn * BM + wc * 32 + 8 * fq;
#pragma unroll
        for (int ai = 0; ai < 2; ++ai)
#pragma unroll
            for (int m = 0; m < 4; ++m) { const size_t off = (size_t)(row0 + ai * HALF + m * 16) * ld + col0;
#pragma unroll
                for (int bj = 0; bj < 2; ++bj) { const f32x4 v0 = acc[ai][bj][m][0] * pre, v1 = acc[ai][bj][m][1] * pre;
                    const u32x4 g = *(const u32x4*)(G + off + bj * HALF);
                    float o[8];
                    o[0] = bf_lo(g.x) * v0[0]; o[1] = bf_hi(g.x) * v0[1]; o[2] = bf_lo(g.y) * v0[2]; o[3] = bf_hi(g.y) * v0[3];
                    o[4] = bf_lo(g.z) * v1[0]; o[5] = bf_hi(g.z) * v1[1]; o[6] = bf_lo(g.w) * v1[2]; o[7] = bf_hi(g.w) * v1[3];
                    if (ADD) { const u32x4 p = *(const u32x4*)(MG + off + bj * HALF);
                        o[0] += bf_lo(p.x); o[1] += bf_hi(p.x); o[2] += bf_lo(p.y); o[3] += bf_hi(p.y); o[4] += bf_lo(p.z); o[5] += bf_hi(p.z); o[6] += bf_lo(p.w); o[7] += bf_hi(p.w); }
                    u32x4 w; w.x = cvt_pk_bf16(o[0], o[1]); w.y = cvt_pk_bf16(o[2], o[3]); w.z = cvt_pk_bf16(o[4], o[5]); w.w = cvt_pk_bf16(o[6], o[7]);
                    *(u32x4*)(MG + off + bj * HALF) = w; }
                asm volatile("" ::: "memory"); }
    }
};
struct EpiResid {
    static constexpr bool PERM = true, AFTER_DRAIN = false;
    const float* X; float* H; bf16_t* HB; float* SSQ; int ld;
    __device__ __forceinline__ void operator()(const f32x4 (&acc)[2][2][4][2], const Unit& u, int wr, int wc, int fr, int fq) const {
        const int row0 = u.pm * BM + wr * 64 + fr; const int col0 = u.pn * BM + wc * 32 + 8 * fq;
#pragma unroll
        for (int ai = 0; ai < 2; ++ai)
#pragma unroll
            for (int m = 0; m < 4; ++m) { const int row = row0 + ai * HALF + m * 16; const size_t off = (size_t)row * ld + col0; float ss = 0.f;
#pragma unroll
                for (int bj = 0; bj < 2; ++bj) {
                    const f32x4 x0 = *(const f32x4*)(X + off + bj * HALF), x1 = *(const f32x4*)(X + off + bj * HALF + 4);
                    const f32x4 h0 = x0 + acc[ai][bj][m][0], h1 = x1 + acc[ai][bj][m][1];
                    u32x4 w; w.x = cvt_pk_bf16(h0[0], h0[1]); w.y = cvt_pk_bf16(h0[2], h0[3]); w.z = cvt_pk_bf16(h1[0], h1[1]); w.w = cvt_pk_bf16(h1[2], h1[3]);
                    *(u32x4*)(HB + off + bj * HALF) = w;
                    ss += (h0[0] * h0[0] + h0[1] * h0[1]) + (h0[2] * h0[2] + h0[3] * h0[3]) + (h1[0] * h1[0] + h1[1] * h1[1]) + (h1[2] * h1[2] + h1[3] * h1[3]); }
                ss += __shfl_xor(ss, 16); ss += __shfl_xor(ss, 32);
                if (fq == 0) SSQ[(size_t)row * 16 + u.pn * 4 + wc] = ss;
                asm volatile("" ::: "memory"); }
    }
};
struct EpiRowScale {
    static constexpr bool PERM = true, AFTER_DRAIN = false;
    bf16_t* O; const float* SSQ; int ldc; float inv_n, eps;
    __device__ __forceinline__ void operator()(const f32x4 (&acc)[2][2][4][2], const Unit& u, int wr, int wc, int fr, int fq) const {
        const int row0 = u.pm * BM + wr * 64 + fr; const int col0 = u.pn * BM + wc * 32 + 8 * fq;
        const int ln = fq * 16 + fr;
        float rsc[2];
#pragma unroll
        for (int ai = 0; ai < 2; ++ai) { const f32x4* sp = (const f32x4*)(SSQ + (size_t)(u.pm * BM + ai * HALF + wr * 64 + ln) * 16); const f32x4 s4 = (sp[0] + sp[1]) + (sp[2] + sp[3]);
            rsc[ai] = __builtin_amdgcn_rsqf(((s4[0] + s4[1]) + (s4[2] + s4[3])) * inv_n + eps); }
#pragma unroll
        for (int ai = 0; ai < 2; ++ai)
#pragma unroll
            for (int m = 0; m < 4; ++m) { const int row = row0 + ai * HALF + m * 16; const float sc = __shfl(rsc[ai], m * 16 + fr);
                bf16_t* rowp = O + (size_t)row * ldc + col0;
#pragma unroll
                for (int bj = 0; bj < 2; ++bj) { const f32x4 v0 = acc[ai][bj][m][0] * sc, v1 = acc[ai][bj][m][1] * sc;
                    u32x4 w; w.x = cvt_pk_bf16(v0[0], v0[1]); w.y = cvt_pk_bf16(v0[2], v0[3]); w.z = cvt_pk_bf16(v1[0], v1[1]); w.w = cvt_pk_bf16(v1[2], v1[3]);
                    *(u32x4*)(rowp + bj * HALF) = w; } }
    }
};

template <class Epi, class Sched, bool ALIGN_EPI = false, bool SP2 = false, bool F8 = false>
__device__ __forceinline__ void gemm_phase(PG8_LAS unsigned char* lds, const Gemm g, const Sched& S, const Epi& E) {
    int tid_ = threadIdx.x; asm volatile("" : "+v"(tid_));
    const int tid = tid_, wid = __builtin_amdgcn_readfirstlane(tid >> 6), lane = tid & 63, wr = wid >> 2, wc = wid & 3, fr = lane & 15, fq = lane >> 4;
    const int K = g.K, nt = K / BK;
    unsigned voffA[2], voffB[2];
#pragma unroll
    for (int i = 0; i < 2; ++i) { int R, C; stage_rc(tid * 16 + i * 8192, R, C); const int Rb = Epi::PERM ? ((R & ~31) + perm32(R & 31)) : R;
        voffA[i] = (unsigned)(R * g.lda + C) * 2u; voffB[i] = (unsigned)(Rb * g.ldb + C) * 2u; }
    const size_t kstep = (size_t)(BK * 2);
    const size_t hstepA = (size_t)HALF * g.lda * 2, hstepB = (size_t)HALF * g.ldb * 2;
    const size_t tstepA = 2 * hstepA, tstepB = 2 * hstepB;
    const unsigned ldsw = (unsigned)wid * 1024u;
    const int aoff = lds_byte(wr * 64 + fr, fq * 8), boff = lds_byte(wc * 32 + fr, fq * 8);
#define PG8_SA(b, h) (((b) * 2 + (h)) * HTB)
#define PG8_SB(b, h) ((4 + (b) * 2 + (h)) * HTB)
#define PG8_STAGE(bufoff, gbase, voff) do { _Pragma("unroll") for (int _i = 0; _i < 2; ++_i) \
        __builtin_amdgcn_global_load_lds((const unsigned*)((const char*)(gbase) + (voff)[_i]), (PG8_LAS unsigned*)(lds + (bufoff) + ldsw + _i * 8192), 16, 0, 0); } while (0)
#define PG8_CAT8(x0, x1) __builtin_shufflevector(x0, x1, 0, 1, 2, 3, 4, 5, 6, 7)
#define PG8_LDA(dst, b, h) do { if constexpr (F8) { _Pragma("unroll") for (int m = 0; m < 4; ++m) dst##8[m] = PG8_CAT8(*(const PG8_LAS v4i_t*)(lds + PG8_SA(b, h) + aoff + m * 2048), *(const PG8_LAS v4i_t*)(lds + PG8_SA(b, h) + aoff + m * 2048 + 1024)); } \
        else { _Pragma("unroll") for (int m = 0; m < 4; ++m) _Pragma("unroll") for (int k = 0; k < 2; ++k) dst[m][k] = *(const PG8_LAS bf16x8*)(lds + PG8_SA(b, h) + aoff + m * 2048 + k * 1024); } } while (0)
#define PG8_LDB(dst, b, h) do { if constexpr (F8) { _Pragma("unroll") for (int n = 0; n < 2; ++n) dst##8[n] = PG8_CAT8(*(const PG8_LAS v4i_t*)(lds + PG8_SB(b, h) + boff + n * 2048), *(const PG8_LAS v4i_t*)(lds + PG8_SB(b, h) + boff + n * 2048 + 1024)); } \
        else { _Pragma("unroll") for (int n = 0; n < 2; ++n) _Pragma("unroll") for (int k = 0; k < 2; ++k) dst[n][k] = *(const PG8_LAS bf16x8*)(lds + PG8_SB(b, h) + boff + n * 2048 + k * 1024); } } while (0)
#define PG8_MMA(ai, bj, At, Bt) do { __builtin_amdgcn_s_setprio(1); \
        if constexpr (F8) { _Pragma("unroll") for (int m = 0; m < 4; ++m) _Pragma("unroll") for (int n = 0; n < 2; ++n) \
            { if (m == 0 && n == 0) asm volatile("s_nop 1\n\tv_mfma_f32_16x16x128_f8f6f4 %0, %1, %2, %0" : "+v"(acc[ai][bj][m][n]) : "v"(Bt##8[n]), "v"(At##8[m]));     \
              else asm volatile("v_mfma_f32_16x16x128_f8f6f4 %0, %1, %2, %0" : "+v"(acc[ai][bj][m][n]) : "v"(Bt##8[n]), "v"(At##8[m])); } } \
        else { _Pragma("unroll") for (int m = 0; m < 4; ++m) _Pragma("unroll") for (int n = 0; n < 2; ++n) _Pragma("unroll") for (int k = 0; k < 2; ++k) \
            acc[ai][bj][m][n] = __builtin_amdgcn_mfma_f32_16x16x32_bf16(Bt[n][k], At[m][k], acc[ai][bj][m][n], 0, 0, 0); } \
        __builtin_amdgcn_s_setprio(0); } while (0)
#define PG8_WAIT_V(n) asm volatile("s_waitcnt vmcnt(" #n ")" ::: "memory")
#define PG8_WAIT_L(n) asm volatile("s_waitcnt lgkmcnt(" #n ")" ::: "memory")
#define PG8_BAR __builtin_amdgcn_s_barrier()
#define PG8_SCHED __builtin_amdgcn_sched_barrier(0)
    Unit cur, nxt; int ui = 0;
    if (!S.next(0, cur)) return;
    f32x4 acc[2][2][4][2];
#pragma unroll
    for (int a = 0; a < 2; ++a)
#pragma unroll
        for (int b = 0; b < 2; ++b)
#pragma unroll
            for (int m = 0; m < 4; ++m)
#pragma unroll
                for (int n = 0; n < 2; ++n) acc[a][b][m][n] = (f32x4){0.f, 0.f, 0.f, 0.f};
    bf16x8 At[4][2], B0[2][2], B1[2][2];
    v8i_t At8[4], B08[2], B18[2];
    const char* cA = (const char*)g.A + (size_t)cur.pm * tstepA; const char* cB = (const char*)g.Bt + (size_t)cur.pn * tstepB;
    S.a_ready(cur);
    if constexpr (SP2) {
        PG8_STAGE(PG8_SB(0, 0), cB, voffB); PG8_STAGE(PG8_SB(0, 1), cB + hstepB, voffB); PG8_STAGE(PG8_SA(0, 0), cA, voffA); PG8_STAGE(PG8_SA(0, 1), cA + hstepA, voffA);
        if (wr == 1) PG8_BAR;
        PG8_WAIT_V(2); PG8_BAR;
        PG8_STAGE(PG8_SB(1, 0), cB + kstep, voffB); PG8_STAGE(PG8_SA(1, 0), cA + kstep, voffA); PG8_STAGE(PG8_SB(1, 1), cB + hstepB + kstep, voffB);
        PG8_WAIT_V(6); PG8_BAR;
    } else {
        PG8_STAGE(PG8_SB(0, 0), cB, voffB); PG8_STAGE(PG8_SA(0, 0), cA, voffA); PG8_STAGE(PG8_SB(0, 1), cB + hstepB, voffB); PG8_STAGE(PG8_SA(0, 1), cA + hstepA, voffA);
        if (wr == 1) PG8_BAR;
        PG8_WAIT_V(4); PG8_BAR;
        PG8_STAGE(PG8_SB(1, 0), cB + kstep, voffB); PG8_STAGE(PG8_SA(1, 0), cA + kstep, voffA); PG8_STAGE(PG8_SB(1, 1), cB + hstepB + kstep, voffB);
        PG8_WAIT_V(6); PG8_BAR;
    }
    for (;;) {
        const bool has_next = S.next(ui + 1, nxt);
        const char* nA = has_next ? (const char*)g.A + (size_t)nxt.pm * tstepA : cA; const char* nB = has_next ? (const char*)g.Bt + (size_t)nxt.pn * tstepB : cB;
#pragma unroll 1
        for (int t = 0; t < nt; t += 2) {
            const bool last = (t == nt - 2);
            const char* a1 = cA + (size_t)(t + 1) * kstep;
            const char* a2 = last ? nA : cA + (size_t)(t + 2) * kstep; const char* b2 = last ? nB : cB + (size_t)(t + 2) * kstep;
            const char* a3 = a2 + kstep; const char* b3 = b2 + kstep;
            if (last && has_next) S.a_ready(nxt);
            if constexpr (SP2) {
            PG8_LDB(B0, 0, 0); PG8_LDB(B1, 0, 1); PG8_SCHED; PG8_LDA(At, 0, 0); PG8_STAGE(PG8_SA(1, 1), a1 + hstepA, voffA);
            PG8_WAIT_V(8); PG8_WAIT_L(0); PG8_BAR; PG8_MMA(0, 0, At, B0); PG8_MMA(0, 1, At, B1); PG8_BAR; PG8_SCHED;
            PG8_LDA(At, 0, 1); PG8_STAGE(PG8_SB(0, 0), b2, voffB); PG8_STAGE(PG8_SB(0, 1), b2 + hstepB, voffB); PG8_STAGE(PG8_SA(0, 0), a2, voffA);
            PG8_WAIT_V(8); PG8_WAIT_L(0); PG8_BAR; PG8_MMA(1, 0, At, B0); PG8_MMA(1, 1, At, B1); PG8_BAR; PG8_SCHED;
            PG8_LDB(B0, 1, 0); PG8_LDB(B1, 1, 1); PG8_SCHED; PG8_LDA(At, 1, 0); PG8_STAGE(PG8_SA(0, 1), a2 + hstepA, voffA);
            PG8_WAIT_V(8); PG8_WAIT_L(0); PG8_BAR; PG8_MMA(0, 0, At, B0); PG8_MMA(0, 1, At, B1); PG8_BAR; PG8_SCHED;
            PG8_LDA(At, 1, 1); PG8_STAGE(PG8_SB(1, 0), b3, voffB); PG8_STAGE(PG8_SB(1, 1), b3 + hstepB, voffB); PG8_STAGE(PG8_SA(1, 0), a3, voffA);
            PG8_WAIT_V(8); PG8_WAIT_L(0); PG8_BAR; PG8_MMA(1, 0, At, B0); PG8_MMA(1, 1, At, B1); PG8_BAR; PG8_SCHED;
            } else {
            PG8_LDB(B0, 0, 0); PG8_SCHED; PG8_LDA(At, 0, 0); PG8_STAGE(PG8_SA(1, 1), a1 + hstepA, voffA);
            PG8_WAIT_L(8); PG8_BAR; PG8_WAIT_L(0); PG8_MMA(0, 0, At, B0); PG8_BAR; PG8_SCHED;
            PG8_LDB(B1, 0, 1); PG8_STAGE(PG8_SB(0, 0), b2, voffB);
            PG8_BAR; PG8_WAIT_L(0); PG8_MMA(0, 1, At, B1); PG8_BAR;
            PG8_LDA(At, 0, 1); PG8_STAGE(PG8_SA(0, 0), a2, voffA);
            PG8_BAR; PG8_WAIT_L(0); PG8_MMA(1, 0, At, B0); PG8_BAR; PG8_SCHED;
            PG8_STAGE(PG8_SB(0, 1), b2 + hstepB, voffB);
            PG8_WAIT_V(6); PG8_BAR; PG8_MMA(1, 1, At, B1); PG8_BAR;
            PG8_LDB(B0, 1, 0); PG8_SCHED; PG8_LDA(At, 1, 0); PG8_STAGE(PG8_SA(0, 1), a2 + hstepA, voffA);
            PG8_WAIT_L(8); PG8_BAR; PG8_WAIT_L(0); PG8_MMA(0, 0, At, B0); PG8_BAR; PG8_SCHED;
            PG8_LDB(B1, 1, 1); PG8_STAGE(PG8_SB(1, 0), b3, voffB);
            PG8_BAR; PG8_WAIT_L(0); PG8_MMA(0, 1, At, B1); PG8_BAR;
            PG8_LDA(At, 1, 1); PG8_STAGE(PG8_SA(1, 0), a3, voffA);
            PG8_BAR; PG8_WAIT_L(0); PG8_MMA(1, 0, At, B0); PG8_BAR; PG8_SCHED;
            PG8_STAGE(PG8_SB(1, 1), b3 + hstepB, voffB);
            PG8_WAIT_V(6); PG8_BAR; PG8_MMA(1, 1, At, B1); PG8_BAR;
            }
        }
        if constexpr (ALIGN_EPI) { if (wr == 0) PG8_BAR; }
        if constexpr (F8) {
            asm volatile("s_nop 15\n\ts_nop 15" : "+v"(acc[0][0][0][0]), "+v"(acc[0][0][0][1]), "+v"(acc[0][0][1][0]), "+v"(acc[0][0][1][1]), "+v"(acc[0][0][2][0]), "+v"(acc[0][0][2][1]), "+v"(acc[0][0][3][0]), "+v"(acc[0][0][3][1]));
            asm volatile("" : "+v"(acc[0][1][0][0]), "+v"(acc[0][1][0][1]), "+v"(acc[0][1][1][0]), "+v"(acc[0][1][1][1]), "+v"(acc[0][1][2][0]), "+v"(acc[0][1][2][1]), "+v"(acc[0][1][3][0]), "+v"(acc[0][1][3][1]));
            asm volatile("" : "+v"(acc[1][0][0][0]), "+v"(acc[1][0][0][1]), "+v"(acc[1][0][1][0]), "+v"(acc[1][0][1][1]), "+v"(acc[1][0][2][0]), "+v"(acc[1][0][2][1]), "+v"(acc[1][0][3][0]), "+v"(acc[1][0][3][1]));
            asm volatile("" : "+v"(acc[1][1][0][0]), "+v"(acc[1][1][0][1]), "+v"(acc[1][1][1][0]), "+v"(acc[1][1][1][1]), "+v"(acc[1][1][2][0]), "+v"(acc[1][1][2][1]), "+v"(acc[1][1][3][0]), "+v"(acc[1][1][3][1]));
        }
        if constexpr (!Epi::AFTER_DRAIN) { E(acc, cur, wr, wc, fr, fq); S.done(cur); }
        if (!has_next) break;
#pragma unroll
        for (int a = 0; a < 2; ++a)
#pragma unroll
            for (int b = 0; b < 2; ++b)
#pragma unroll
                for (int m = 0; m < 4; ++m)
#pragma unroll
                    for (int n = 0; n < 2; ++n) acc[a][b][m][n] = (f32x4){0.f, 0.f, 0.f, 0.f};
        cur = nxt; cA = nA; cB = nB; ++ui;
        if constexpr (ALIGN_EPI) { if (wr == 1) PG8_BAR; }
    }
    PG8_WAIT_V(0);
    if constexpr (!ALIGN_EPI) { if (wr == 0) PG8_BAR; }
    PG8_BAR;
    if constexpr (Epi::AFTER_DRAIN) { E.fused(acc, cur, wr, wc, fr, fq, lds, wid, lane); S.done(cur); }
#undef PG8_SA
#undef PG8_SB
#undef PG8_STAGE
#undef PG8_LDA
#undef PG8_LDB
#undef PG8_MMA
#undef PG8_CAT8
#undef PG8_WAIT_V
#undef PG8_WAIT_L
#undef PG8_BAR
#undef PG8_SCHED
}
}

constexpr int NTOK = 65536, SEQ = 8192, NBATCH = 8, DM = 1024, INC = 6672, P1N = 4608, NCHUNK = SEQ / 64;
constexpr float EPS = 1e-6f;
constexpr int NWAVES = 8, NTHREADS = 512;
constexpr int LDS_BYTES = 147456;
constexpr int XB_ST_OFF = LDS_BYTES - 512;
constexpr size_t MiB = (size_t)1 << 20;
constexpr size_t WS_SSQ = 1008 * MiB;
constexpr size_t WS_KEYS = 1 * MiB;
constexpr size_t WS_POOLW = 1 * MiB + 512 * 1024;
constexpr size_t WS_WPU = 2 * MiB, WS_WDU = 3 * MiB, WS_WMX = 5 * MiB, WS_WQ = 7 * MiB, WS_WIN = 11 * MiB;
constexpr size_t WS_EDOWN = 24 * MiB, WS_EUP = 56 * MiB;
constexpr float ED_SCALE = 32.0f, EU_SCALE = 4.0f;
constexpr size_t WS_BETA = 88 * MiB, WS_GRAW = 90 * MiB, WS_GC = 92 * MiB;
constexpr size_t WS_HALO = 94 * MiB;
constexpr size_t WS_POOLED = 112 * MiB;
constexpr size_t WS_WBUF = 176 * MiB;
constexpr size_t WS_ABUF = 304 * MiB;
constexpr size_t WS_PROJ = 432 * MiB;
constexpr size_t WS_Q2 = WS_PROJ, WS_IDX = WS_PROJ + 256 * MiB, WS_GATEW = WS_PROJ + 288 * MiB;
constexpr size_t WS_END = 1012 * MiB;
constexpr float ON8_SCALE = 4.0f;
constexpr float XN8_SCALE = 4.0f, WG8_SCALE = 64.0f;
constexpr int C_XA = 0, C_Q = 512, C_K = 1536, C_V = 2560, C_Z = 3584;

#define LAS __attribute__((address_space(3)))
typedef unsigned short bf16_t;
typedef short bf16x8 __attribute__((ext_vector_type(8)));
typedef float f32x4 __attribute__((ext_vector_type(4)));
typedef unsigned u32x4 __attribute__((ext_vector_type(4)));
typedef unsigned u32x2 __attribute__((ext_vector_type(2)));
#define LDS_WAIT() asm volatile("s_waitcnt lgkmcnt(0)" ::: "memory")
#define VM_WAIT() asm volatile("s_waitcnt vmcnt(0)" ::: "memory")

__device__ __forceinline__ unsigned pk2(float lo, float hi) { return pg8::cvt_pk_bf16(lo, hi); }
__device__ __forceinline__ unsigned short f2bf(float f) { return (unsigned short)(pg8::cvt_pk_bf16(f, 0.f) & 0xffffu); }
__device__ __forceinline__ float bflo(unsigned w) { return __uint_as_float(w << 16); }
__device__ __forceinline__ float bfhi(unsigned w) { return __uint_as_float(w & 0xffff0000u); }
__device__ __forceinline__ float bf2f(unsigned short b) { return __uint_as_float((unsigned)b << 16); }
__device__ __forceinline__ void unpack8(const u32x4 w, float* f) { f[0] = bflo(w.x); f[1] = bfhi(w.x); f[2] = bflo(w.y); f[3] = bfhi(w.y); f[4] = bflo(w.z); f[5] = bfhi(w.z); f[6] = bflo(w.w); f[7] = bfhi(w.w); }
__device__ __forceinline__ u32x4 pack8(const float* f) { u32x4 w; w.x = pk2(f[0], f[1]); w.y = pk2(f[2], f[3]); w.z = pk2(f[4], f[5]); w.w = pk2(f[6], f[7]); return w; }
__device__ __forceinline__ float wave_sum(float v) {
#pragma unroll
    for (int o = 1; o < 64; o <<= 1) v += __shfl_xor(v, o);
    return v;
}
__device__ __forceinline__ f32x4 mfma16(bf16x8 a, bf16x8 b, f32x4 c) { return __builtin_amdgcn_mfma_f32_16x16x32_bf16(a, b, c, 0, 0, 0); }
__device__ __forceinline__ bf16x8 ldfrag(const LAS bf16_t* p, int ld, int row0, int k0, int lane) { return *(const LAS bf16x8*)(p + (row0 + (lane & 15)) * ld + k0 + 8 * (lane >> 4)); }

struct Params { const float* in[19]; float* out; unsigned char* ws; };

struct Frame {
    LAS unsigned char* lds;
    int tid, lane, wave, vcu, G;
    int sl_s, sl_rk, sl_n;
    __device__ __forceinline__ void fresh() { int t = threadIdx.x; asm volatile("" : "+v"(t)); tid = t; lane = t & 63; wave = __builtin_amdgcn_readfirstlane(t >> 6); }
    const float *x, *mix_norm_w, *w_in, *pool_w, *pool_scale, *conv_w, *a_log, *dt_bias, *dn_norm_w, *w_pool_up, *w_dn_up, *w_mix_out, *ffn_norm_w, *w_query, *keys1, *keys2, *peer_down, *peer_up, *final_norm_w;
    float* out; unsigned char* ws;
};


#ifdef TIMING_A
#define TACC_T0() const unsigned long long tacc_t0_ = __builtin_amdgcn_s_memrealtime()
#define TACC_ADD(k) do { if (blockIdx.x == 0 && threadIdx.x == 0) ((volatile LAS unsigned long long*)(F.lds + LDS_BYTES - 256 + 128))[(k)] += __builtin_amdgcn_s_memrealtime() - tacc_t0_; } while (0)
#else
#define TACC_T0() do {} while (0)
#define TACC_ADD(k) do {} while (0)
#endif
__device__ __forceinline__ unsigned pack4_fp8(float a, float b, float c, float d, float s) {
    a = __builtin_amdgcn_fmed3f(a * s, -448.f, 448.f); b = __builtin_amdgcn_fmed3f(b * s, -448.f, 448.f); c = __builtin_amdgcn_fmed3f(c * s, -448.f, 448.f); d = __builtin_amdgcn_fmed3f(d * s, -448.f, 448.f);
    int v = __builtin_amdgcn_cvt_pk_fp8_f32(a, b, 0, false); v = __builtin_amdgcn_cvt_pk_fp8_f32(c, d, v, true); return (unsigned)v; }
__device__ __forceinline__ void p0_transpose_item(const float* W, int ldw, int c0, const float* kscale, int K, bf16_t* WT, int nblk, LAS float* scr, int item, int lane, float f8s = 0.f) {
    const int kb = item / nblk, nb = item % nblk, k0 = 64 * kb, n0 = 32 * nb;
#pragma unroll 8
    for (int i = 0; i < 32; ++i) { const int kk = 2 * i + (lane >> 5); float v = W[(size_t)(k0 + kk) * ldw + c0 + n0 + (lane & 31)]; if (kscale) v *= kscale[k0 + kk]; scr[kk * 33 + (lane & 31)] = v; }
    LDS_WAIT();
    const int c = lane & 7;
#pragma unroll
    for (int j = 0; j < 4; ++j) { const int n = (lane >> 3) + 8 * j; const LAS float* s = scr + (8 * c) * 33 + n;
        if (f8s != 0.f) { const unsigned v0 = pack4_fp8(s[0 * 33], s[1 * 33], s[2 * 33], s[3 * 33], f8s), v1 = pack4_fp8(s[4 * 33], s[5 * 33], s[6 * 33], s[7 * 33], f8s);
            u32x2 o8; o8.x = v0; o8.y = v1; *(u32x2*)((unsigned char*)WT + (size_t)(n0 + n) * K + k0 + 8 * c) = o8; }
        else { u32x4 o; o.x = pk2(s[0 * 33], s[1 * 33]); o.y = pk2(s[2 * 33], s[3 * 33]); o.z = pk2(s[4 * 33], s[5 * 33]); o.w = pk2(s[6 * 33], s[7 * 33]);
            *(u32x4*)(WT + (size_t)(n0 + n) * K + k0 + 8 * c) = o; } }
    LDS_WAIT();
}
__device__ __forceinline__ float softplusf_(float x) { return x > 15.f ? x : log1pf(expf(x)); }

__device__ __forceinline__ void p0_prologue(Frame& F) {
    F.fresh();
    const int gw = F.vcu * NWAVES + F.wave, NGW = F.G * NWAVES;
    const int gt = F.vcu * NTHREADS + F.tid, NGT = F.G * NTHREADS;
    unsigned char* ws = F.ws;
    {
        LAS float* scr = (LAS float*)(F.lds + F.wave * 8448);
        constexpr int I_IN1 = 16 * (P1N / 32), I_IN2 = 16 * (2048 / 32), I_DU = 16 * 32, I_MX = 16 * 32, I_WQ = 16 * 64;
        constexpr int NITEMS = I_IN1 + I_IN2 + I_DU + I_MX + I_WQ;
        bf16_t* WIN = (bf16_t*)(ws + WS_WIN);
#pragma unroll 1
        for (int it = gw; it < NITEMS; it += NGW) {
            int r = it;
            if (r < I_IN1) { p0_transpose_item(F.w_in, INC, 0, nullptr, DM, WIN, P1N / 32, scr, r, F.lane); continue; } r -= I_IN1;
            if (r < I_IN2) { p0_transpose_item(F.w_in, INC, 4624, nullptr, DM, WIN + (size_t)P1N * DM, 2048 / 32, scr, r, F.lane, WG8_SCALE); continue; } r -= I_IN2;
            if (r < I_DU) { p0_transpose_item(F.w_dn_up, DM, 0, nullptr, DM, (bf16_t*)(ws + WS_WDU), 32, scr, r, F.lane, WG8_SCALE); continue; } r -= I_DU;
            if (r < I_MX) { p0_transpose_item(F.w_mix_out, DM, 0, nullptr, DM, (bf16_t*)(ws + WS_WMX), 32, scr, r, F.lane); continue; } r -= I_MX;
            { p0_transpose_item(F.w_query, 2048, 0, F.ffn_norm_w, DM, (bf16_t*)(ws + WS_WQ), 64, scr, r, F.lane); }
        }
    }
    {
        bf16_t* WPU = (bf16_t*)(ws + WS_WPU);
#pragma unroll 1
        for (int it = gt; it < 128 * 256; it += NGT) {
            const int k0 = (it >> 8) * 4, n4 = (it & 255) * 4, g = k0 >> 7;
            const float* pw = F.pool_w + (size_t)k0 * 128;
            const float* sc = F.pool_scale + g * 128;
            const float* wu = F.w_pool_up + (size_t)(g * 128) * DM + n4;
            f32x4 acc[4];
#pragma unroll
            for (int i = 0; i < 4; ++i) acc[i] = (f32x4){0.f, 0.f, 0.f, 0.f};
#pragma unroll 4
            for (int d = 0; d < 128; ++d) { const f32x4 w4 = *(const f32x4*)(wu + (size_t)d * DM) * sc[d];
#pragma unroll
                for (int i = 0; i < 4; ++i) acc[i] = acc[i] + w4 * pw[128 * i + d]; }
#pragma unroll
            for (int j = 0; j < 4; ++j) { u32x2 o; o.x = pk2(acc[0][j], acc[1][j]); o.y = pk2(acc[2][j], acc[3][j]); *(u32x2*)(WPU + (size_t)(n4 + j) * 512 + k0) = o; }
        }
    }
    {
        bf16_t* KEYS = (bf16_t*)(ws + WS_KEYS);
#pragma unroll 1
        for (int i = gt; i < 2 * 8 * 128 * 128 / 4; i += NGT) {
            const int e = i * 4; const int p = e / (8 * 128 * 128), r = e % (8 * 128 * 128), h = r / (128 * 128), q = r % (128 * 128);
            const f32x4 v = *(const f32x4*)((p ? F.keys2 : F.keys1) + r);
            u32x2 o; o.x = pk2(v[0], v[1]); o.y = pk2(v[2], v[3]);
            *(u32x2*)(KEYS + ((size_t)(h * 2 + p) * 128 * 128 + q)) = o;
        }
    }
    __syncthreads();
    {
        LAS float* wbd = (LAS float*)F.lds;
        for (int i = F.tid; i < 16 * 1024; i += NTHREADS) { const int c = i & 15, k = i >> 4; wbd[c * 1024 + k] = F.w_in[(size_t)k * INC + 4608 + c]; }
        __syncthreads();
        bf16_t* XN = (bf16_t*)F.out; unsigned* XN8 = (unsigned*)(ws + WS_ABUF + 64 * MiB);
        float* BETA = (float*)(ws + WS_BETA); float* GRAW = (float*)(ws + WS_GRAW);
        f32x4 nw[4];
#pragma unroll
        for (int j = 0; j < 4; ++j) nw[j] = *((const f32x4*)F.mix_norm_w + F.lane + 64 * j);
        const int x4 = F.lane & 15, cm = ((x4 & 1) << 3) | ((x4 & 2) << 1) | ((x4 & 4) >> 1) | ((x4 & 8) >> 3), hh = cm & 7;
        const float alog_e = expf(F.a_log[hh]), dtb = F.dt_bias[hh];
        f32x4 vn[4];
        if (gw < NTOK) { const f32x4* xr = (const f32x4*)(F.x + (size_t)gw * DM) + F.lane;
#pragma unroll
            for (int j = 0; j < 4; ++j) vn[j] = xr[64 * j]; }
#pragma unroll 1
        for (int m = gw; m < NTOK; m += NGW) {
            f32x4 v[4]; float s = 0.f;
#pragma unroll
            for (int j = 0; j < 4; ++j) { v[j] = vn[j]; s += (v[j][0] * v[j][0] + v[j][1] * v[j][1]) + (v[j][2] * v[j][2] + v[j][3] * v[j][3]); }
            { const int mn = (m + NGW < NTOK) ? m + NGW : m; const f32x4* xr = (const f32x4*)(F.x + (size_t)mn * DM) + F.lane;
#pragma unroll
              for (int j = 0; j < 4; ++j) vn[j] = xr[64 * j]; }
            const float rstd = __builtin_amdgcn_rsqf(wave_sum(s) * (1.f / DM) + EPS);
            unsigned long long* o8 = (unsigned long long*)(XN + (size_t)m * DM) + F.lane;
#pragma unroll
            for (int j = 0; j < 4; ++j) { v[j] = v[j] * rstd * nw[j]; o8[64 * j] = (unsigned long long)pk2(v[j][0], v[j][1]) | ((unsigned long long)pk2(v[j][2], v[j][3]) << 32);
                XN8[(size_t)m * (DM / 4) + 64 * j + F.lane] = pack4_fp8(v[j][0], v[j][1], v[j][2], v[j][3], XN8_SCALE); }
            float pd[16];
#pragma unroll
            for (int c = 0; c < 16; ++c) {
                float a = 0.f;
#pragma unroll
                for (int j = 0; j < 4; ++j) { const f32x4 w4 = *(const LAS f32x4*)(wbd + c * 1024 + 256 * j + 4 * F.lane); a += (v[j][0] * w4[0] + v[j][1] * w4[1]) + (v[j][2] * w4[2] + v[j][3] * w4[3]); }
                pd[c] = a;
                if (c & 1) asm volatile("" ::: "memory");
            }
            float q8[8], q4[4], q2[2];
            { const bool hi = F.lane & 1;
#pragma unroll
              for (int k = 0; k < 8; ++k) { const float keep = hi ? pd[8 + k] : pd[k], send = hi ? pd[k] : pd[8 + k]; q8[k] = keep + __shfl_xor(send, 1); } }
            { const bool hi = F.lane & 2;
#pragma unroll
              for (int k = 0; k < 4; ++k) { const float keep = hi ? q8[4 + k] : q8[k], send = hi ? q8[k] : q8[4 + k]; q4[k] = keep + __shfl_xor(send, 2); } }
            { const bool hi = F.lane & 4;
#pragma unroll
              for (int k = 0; k < 2; ++k) { const float keep = hi ? q4[2 + k] : q4[k], send = hi ? q4[k] : q4[2 + k]; q2[k] = keep + __shfl_xor(send, 4); } }
            float mine; { const bool hi = F.lane & 8; const float keep = hi ? q2[1] : q2[0], send = hi ? q2[0] : q2[1]; mine = keep + __shfl_xor(send, 8); }
            mine += __shfl_xor(mine, 16); mine += __shfl_xor(mine, 32);
            if (F.lane < 16) {
                if (cm < 8) BETA[(size_t)m * 8 + cm] = 1.0f / (1.0f + expf(-mine));
                else GRAW[(size_t)m * 8 + (cm - 8)] = -alog_e * softplusf_(mine + dtb);
            }
        }
    }
}

template <int WIN> __device__ __forceinline__ void pool_run4(const bf16_t* src, int s0, bf16_t* dst) {
    u32x4 rows[WIN + 3];
#pragma unroll
    for (int k = 0; k < WIN + 3; ++k) { const int d = k - (WIN - 1); rows[k] = (s0 + d >= 0) ? *(const u32x4*)(src + (ptrdiff_t)d * P1N) : (u32x4){0u, 0u, 0u, 0u}; }
    float sum[8];
#pragma unroll
    for (int i = 0; i < 8; ++i) sum[i] = 0.f;
#pragma unroll
    for (int k = 0; k < WIN; ++k) { float f[8]; unpack8(rows[k], f);
#pragma unroll
        for (int i = 0; i < 8; ++i) sum[i] += f[i]; }
#pragma unroll
    for (int j = 0; j < 4; ++j) {
        float cur[8]; unpack8(rows[WIN - 1 + j], cur);
        const int cnt = (s0 + j + 1 < WIN) ? (s0 + j + 1) : WIN; const float inv = __builtin_amdgcn_rcpf((float)cnt);
        float o[8];
#pragma unroll
        for (int i = 0; i < 8; ++i) o[i] = sum[i] * inv - cur[i];
        *(u32x4*)(dst + (size_t)j * 512) = pack8(o);
        if (j < 3) { float fa[8], fs[8]; unpack8(rows[WIN + j], fa); unpack8(rows[j], fs);
#pragma unroll
            for (int i = 0; i < 8; ++i) sum[i] += fa[i] - fs[i]; }
    }
}
__device__ __forceinline__ void p2h_pool(Frame& F) {
    F.fresh();
    const bf16_t* PROJ = (const bf16_t*)(F.ws + WS_PROJ); bf16_t* POOLED = (bf16_t*)(F.ws + WS_POOLED);
    for (int u = F.vcu; u < 512 * 4; u += F.G) {
        const int g = u & 3, tt = u >> 2;
        const int cg = F.tid & 15, run = F.tid >> 4; const int tl0 = 4 * run; const int t = tt * 128 + tl0, s0 = t & (SEQ - 1);
        const bf16_t* src = PROJ + (size_t)t * P1N + C_XA + g * 128 + cg * 8;
        bf16_t* dst = POOLED + (size_t)t * 512 + g * 128 + cg * 8;
        switch (g) { case 0: pool_run4<2>(src, s0, dst); break; case 1: pool_run4<4>(src, s0, dst); break; case 2: pool_run4<8>(src, s0, dst); break; default: pool_run4<16>(src, s0, dst); break; }
    }
}

template <int CTRL> __device__ __forceinline__ float dpp_f(float v) { return __int_as_float(__builtin_amdgcn_update_dpp(0, __float_as_int(v), CTRL, 0xF, 0xF, false)); }
__device__ __forceinline__ float x16sum(float x) { typedef unsigned u32x2s __attribute__((ext_vector_type(2))); const u32x2s r = __builtin_amdgcn_permlane16_swap(__float_as_uint(x), __float_as_uint(x), false, false); return __uint_as_float(r[0]) + __uint_as_float(r[1]); }
constexpr int Q2_QN = 0, Q2_KN = 17408, Q2_VBT = 34816, Q2_KBGT = 51200, Q2_LM = 67584, Q2_TF = 84992, Q2_TB = 102400, Q2_AST = 111616, Q2_SCAL = 120832, Q2_PART = 121344, Q2_WSCR = 129536;
struct P2Out { bf16_t* qg; bf16_t* kd; bf16_t* uo; int ld; bf16_t* wo; bf16_t* ao; float* gc; size_t tok0; int unit0; int nunits; };
__device__ __forceinline__ void conv_silu4(const u32x2 r0, const u32x2 r1, const u32x2 r2, const u32x2 r3, const float (&wj)[4][4], float* sv) {
    const float x0[4] = {bflo(r0.x), bfhi(r0.x), bflo(r0.y), bfhi(r0.y)}, x1[4] = {bflo(r1.x), bfhi(r1.x), bflo(r1.y), bfhi(r1.y)};
    const float x2[4] = {bflo(r2.x), bfhi(r2.x), bflo(r2.y), bfhi(r2.y)}, x3[4] = {bflo(r3.x), bfhi(r3.x), bflo(r3.y), bfhi(r3.y)};
#pragma unroll
    for (int i = 0; i < 4; ++i) { const float y = (wj[0][i] * x0[i] + wj[1][i] * x1[i]) + (wj[2][i] * x2[i] + wj[3][i] * x3[i]); sv[i] = y * __builtin_amdgcn_rcpf(1.0f + __expf(-y)); }
}
__device__ __forceinline__ int swz8(int row) { return (row ^ (row >> 3)) & 7; }
__device__ __forceinline__ bf16x8 ldfrag_swz(const LAS bf16_t* p, int row0, int k0, int lane) { const int row = row0 + (lane & 15); const int ch = ((k0 >> 3) + (lane >> 4)) ^ swz8(row); return *(const LAS bf16x8*)(p + row * 64 + ch * 8); }
__device__ __forceinline__ f32x4 mfma4f(float a, float b, f32x4 c) { return __builtin_amdgcn_mfma_f32_16x16x4f32(a, b, c, 0, 0, 0); }
__device__ __forceinline__ void tri_block(const LAS float* LM, LAS float* TF, LAS bf16_t* TB, LAS float* scr, int a, int b, int lane) {
    const int fr = lane & 15, fq = lane >> 4;
    f32x4 acc = (f32x4){0.f, 0.f, 0.f, 0.f};
    for (int k = b; k < a; ++k) {
#pragma unroll
        for (int s = 0; s < 4; ++s) acc = mfma4f(LM[(16 * a + fr) * 68 + 16 * k + 4 * s + fq], TF[(16 * k + 4 * s + fq) * 68 + 16 * b + fr], acc);
    }
#pragma unroll
    for (int r = 0; r < 4; ++r) scr[(fq * 4 + r) * 17 + fr] = acc[r];
    LDS_WAIT();
    f32x4 acc2 = (f32x4){0.f, 0.f, 0.f, 0.f};
#pragma unroll
    for (int s = 0; s < 4; ++s) acc2 = mfma4f(TF[(16 * a + fr) * 68 + 16 * a + 4 * s + fq], scr[(4 * s + fq) * 17 + fr], acc2);
#pragma unroll
    for (int r = 0; r < 4; ++r) { const int row = 16 * a + fq * 4 + r, col = 16 * b + fr; const float v = -acc2[r]; TF[row * 68 + col] = v; TB[row * 72 + col] = f2bf(v); }
}
__device__ __forceinline__ void p2_chunk_prep(Frame& F, const P2Out O) {
    F.fresh();
    const bf16_t* PROJ = (const bf16_t*)(F.ws + WS_PROJ); const bf16_t* HALO = (const bf16_t*)(F.ws + WS_HALO);
    const float* BETA = (const float*)(F.ws + WS_BETA); const float* GRAW = (const float*)(F.ws + WS_GRAW);
    LAS bf16_t* QN = (LAS bf16_t*)(F.lds + Q2_QN); LAS bf16_t* KN = (LAS bf16_t*)(F.lds + Q2_KN); LAS bf16_t* VBT = (LAS bf16_t*)(F.lds + Q2_VBT); LAS bf16_t* KBGT = (LAS bf16_t*)(F.lds + Q2_KBGT);
    LAS float* LM = (LAS float*)(F.lds + Q2_LM); LAS float* TF = (LAS float*)(F.lds + Q2_TF); LAS bf16_t* TB = (LAS bf16_t*)(F.lds + Q2_TB); LAS bf16_t* AST = (LAS bf16_t*)(F.lds + Q2_AST);
    LAS float* SBETA = (LAS float*)(F.lds + Q2_SCAL); LAS float* SGC = SBETA + 64; LAS float* SFQ = (LAS float*)(F.lds + Q2_PART); LAS float* SFK = SFQ + 64; LAS float* SF2 = SFQ + 128;
    const int tid = F.tid, lane = F.lane, w = F.wave;
    LAS float* scr = (LAS float*)(F.lds + Q2_WSCR) + w * 272;
    const float scale = 0.08838834764831845f;
    const int typ = (w < 4) ? (w >> 1) : 2, cc = tid & 31;
    const int tokb = (w < 4) ? 16 * ((tid & 127) >> 5) : 8 * ((tid - 256) >> 5), ng4 = (w < 4) ? 4 : 2;
    for (int i = tid; i < 64 * 72 / 2; i += NTHREADS) ((LAS unsigned*)TB)[i] = 0u;
    u32x2 raw[19]; float pbeta = 0.f, pg = 0.f;
#define P2_LOAD(uu) do { const int h_ = (uu) & 7, bn_ = (uu) >> 3, n_ = bn_ % NCHUNK, b_ = bn_ / NCHUNK; const size_t t0_ = (size_t)b_ * SEQ + (size_t)n_ * 64; \
        { const int col_ = C_Q + typ * 1024 + h_ * 128 + cc * 4; int tokb_ = tokb; asm volatile("" : "+v"(tokb_));     \
            \
          _Pragma("unroll") for (int rr = 0; rr < 3; ++rr) { const bf16_t* p_ = (tokb_ == 0) ? HALO + ((size_t)bn_ * 3 + rr) * 3072 + (col_ - C_Q) : PROJ + (t0_ + tokb_ - 3 + rr) * P1N + col_; \
              if (tokb_ == 0 && n_ == 0) raw[rr] = (u32x2){0u, 0u}; else raw[rr] = *(const u32x2*)p_; }     \
          { const bf16_t* pb_ = PROJ + (t0_ + tokb_) * P1N + col_; \
            if (w < 4) { _Pragma("unroll") for (int rr = 3; rr < 19; ++rr) raw[rr] = *(const u32x2*)(pb_ + (size_t)(rr - 3) * P1N); } \
            else { _Pragma("unroll") for (int rr = 3; rr < 11; ++rr) raw[rr] = *(const u32x2*)(pb_ + (size_t)(rr - 3) * P1N); } } } \
        if (w == 7) { pbeta = BETA[(t0_ + lane) * 8 + h_]; pg = GRAW[(t0_ + lane) * 8 + h_]; } } while (0)
    const size_t TNGT = (size_t)F.G * NTHREADS; constexpr size_t TB_TOT = (size_t)16384 * 1024 / 4;
    const int TB_N = (int)((TB_TOT + TNGT - 1) / TNGT); int tb_it = 0;
    f32x4 td_ = (f32x4){0.f, 0.f, 0.f, 0.f}, tu_ = td_; bool tv_ = false;
#define P2_TBL_ISSUE() do { int tq_ = threadIdx.x; asm volatile("" : "+v"(tq_)); const size_t i_ = (size_t)F.vcu * NTHREADS + tq_ + (size_t)tb_it * TNGT; tv_ = (tb_it < TB_N) && (i_ < TB_TOT); \
        if (tv_) { td_ = *(const f32x4*)(F.peer_down + i_ * 4); tu_ = *(const f32x4*)(F.peer_up + i_ * 4); } } while (0)
#define P2_TBL_FINISH() do { if (tv_) { int tq_ = threadIdx.x; asm volatile("" : "+v"(tq_)); const size_t i_ = (size_t)F.vcu * NTHREADS + tq_ + (size_t)tb_it * TNGT; const size_t e_ = i_ * 4; const int k_ = (int)(e_ & 1023); \
            const f32x4 nw_ = *(const f32x4*)(F.ffn_norm_w + k_); const f32x4 d_ = td_ * nw_ * ED_SCALE, u_ = tu_ * EU_SCALE; \
            const size_t di_ = ((size_t)(k_ >> 7) * (16384 * 128) + (e_ >> 10) * 128 + (k_ & 127)) >> 2; \
            ((unsigned*)(F.ws + WS_EDOWN))[di_] = pack4_fp8(d_[0], d_[1], d_[2], d_[3], 1.0f); ((unsigned*)(F.ws + WS_EUP))[di_] = pack4_fp8(u_[0], u_[1], u_[2], u_[3], 1.0f); } \
        ++tb_it; } while (0)
    const int u_end = O.unit0 + O.nunits;
    int u = O.unit0 + F.vcu;
    if (u < u_end) P2_LOAD(u);
    for (; u < u_end; u += F.G) {
        const int h = u & 7, bn = u >> 3, n = bn % NCHUNK, b = bn / NCHUNK; const size_t t0 = (size_t)b * SEQ + (size_t)n * 64; const size_t tr0 = t0 - O.tok0;
        const int col = C_Q + typ * 1024 + h * 128 + cc * 4;
        VM_WAIT();
        if (w == 7) {
            float g = pg;
#pragma unroll
            for (int o = 1; o < 64; o <<= 1) { const float up = __shfl_up(g, o); if (lane >= o) g += up; }
            SBETA[lane] = pbeta; SGC[lane] = g; O.gc[(tr0 + lane) * 8 + h] = g;
            { const float eg = __expf(g), glast = __shfl(g, 63); SFQ[lane] = scale * eg; SFK[lane] = __expf(glast - g); SF2[lane] = pbeta * eg; }
        }
        float wj[4][4];
        {
#pragma unroll
            for (int j = 0; j < 4; ++j) { const f32x4 a = *(const f32x4*)(F.conv_w + (size_t)j * 3072 + (col - C_Q)); wj[j][0] = a[0]; wj[j][1] = a[1]; wj[j][2] = a[2]; wj[j][3] = a[3]; }
        }
        __syncthreads();
        {
            LAS bf16_t* lrow = ((typ == 0) ? QN : KN) + tokb * 136 + cc * 4;
            bf16_t* grow = ((typ == 0) ? O.qg : O.kd) + (tr0 + tokb) * O.ld + h * 128 + cc * 4;
            const LAS float* sb = ((typ == 2) ? SBETA : SF2) + tokb; const LAS float* sg = ((typ == 0) ? SFQ : SFK) + tokb;
            LAS bf16_t* dst = (typ == 1) ? KBGT : VBT;
#pragma unroll 1
            for (int g4 = 0; g4 < ng4; ++g4) {
                unsigned xp[2][4]; float xe[4];
                float xr[7][4];
#pragma unroll
                for (int q7 = 0; q7 < 7; ++q7) { xr[q7][0] = bflo(raw[q7].x); xr[q7][1] = bfhi(raw[q7].x); xr[q7][2] = bflo(raw[q7].y); xr[q7][3] = bfhi(raw[q7].y); }
#pragma unroll
                for (int t4 = 0; t4 < 4; ++t4) {
                    float sv[4];
#pragma unroll
                    for (int i = 0; i < 4; ++i) { const float y = (wj[0][i] * xr[t4][i] + wj[1][i] * xr[t4 + 1][i]) + (wj[2][i] * xr[t4 + 2][i] + wj[3][i] * xr[t4 + 3][i]); sv[i] = y * __builtin_amdgcn_rcpf(1.0f + __expf(-y)); }
                    const float be = sb[t4];
                    float xo[4];
                    if (typ < 2) {
                        float tot = (sv[0] * sv[0] + sv[1] * sv[1]) + (sv[2] * sv[2] + sv[3] * sv[3]);
                        tot += dpp_f<0xB1>(tot); tot += dpp_f<0x4E>(tot); tot += dpp_f<0x141>(tot); tot += dpp_f<0x140>(tot); tot = x16sum(tot);
                        const float rn = __builtin_amdgcn_rsqf(tot + EPS);
                        float nv[4], ov[4];
#pragma unroll
                        for (int i = 0; i < 4; ++i) nv[i] = sv[i] * rn;
                        { u32x2 v; v.x = pk2(nv[0], nv[1]); v.y = pk2(nv[2], nv[3]); *(LAS u32x2*)lrow = v; }
                        const float f = sg[t4], f2 = be;
#pragma unroll
                        for (int i = 0; i < 4; ++i) { ov[i] = nv[i] * f; xo[i] = nv[i] * f2; }
                        { u32x2 v; v.x = pk2(ov[0], ov[1]); v.y = pk2(ov[2], ov[3]); *(u32x2*)grow = v; }
                        lrow += 136; grow += O.ld;
                    } else {
#pragma unroll
                        for (int i = 0; i < 4; ++i) xo[i] = sv[i] * be;
                    }
                    if (t4 & 1) {
#pragma unroll
                        for (int i = 0; i < 4; ++i) xp[t4 >> 1][i] = pk2(xe[i], xo[i]);
                    } else {
#pragma unroll
                        for (int i = 0; i < 4; ++i) xe[i] = xo[i];
                    }
                }
                if (typ >= 1) {
                    const int tk = tokb + 4 * g4;
#pragma unroll
                    for (int i = 0; i < 4; ++i) { const int row = cc * 4 + i; u32x2 v; v.x = xp[0][i]; v.y = xp[1][i];
                        *(LAS u32x2*)(dst + row * 64 + (((tk >> 3) ^ swz8(row)) * 8) + (tk & 4)) = v; }
                }
#pragma unroll
                for (int i = 0; i < 15; ++i) raw[i] = raw[i + 4];
                sb += 4; sg += 4;
            }
        }
        if (u + F.G < u_end) P2_LOAD(u + F.G);
        P2_TBL_ISSUE();
        __syncthreads();
        {
            const int mi = w & 3; const bool isq = w >= 4;
            f32x4 acc[4];
#pragma unroll
            for (int ni = 0; ni < 4; ++ni) acc[ni] = (f32x4){0.f, 0.f, 0.f, 0.f};
#pragma unroll
            for (int k0 = 0; k0 < 128; k0 += 32) { const bf16x8 a = ldfrag(isq ? QN : KN, 136, mi * 16, k0, lane);
#pragma unroll
                for (int ni = 0; ni < 4; ++ni) acc[ni] = mfma16(a, ldfrag(KN, 136, ni * 16, k0, lane), acc[ni]); }
            float gi[4], bi[4], gj[4];
#pragma unroll
            for (int r = 0; r < 4; ++r) { gi[r] = SGC[mi * 16 + (lane >> 4) * 4 + r]; bi[r] = SBETA[mi * 16 + (lane >> 4) * 4 + r]; gj[r] = SGC[r * 16 + (lane & 15)]; }
#pragma unroll
            for (int ni = 0; ni < 4; ++ni)
#pragma unroll
                for (int r = 0; r < 4; ++r) { const int i = mi * 16 + (lane >> 4) * 4 + r, j = ni * 16 + (lane & 15);
                    const float dec = __expf(fminf(gi[r] - gj[ni], 0.f));
                    if (!isq) LM[i * 68 + j] = (i > j) ? bi[r] * acc[ni][r] * dec : 0.f;
                    else AST[i * 72 + j] = f2bf((i >= j) ? acc[ni][r] * scale * dec : 0.f); }
        }
        __syncthreads();
        { const int row = tid >> 3, ch = tid & 7; *(u32x4*)(O.ao + (size_t)(u - O.unit0) * 4096 + row * 64 + ch * 8) = *(const LAS u32x4*)(AST + row * 72 + ch * 8); }
        if (w < 4) {
            const int a = w, c = lane & 15;
            float Lr[16];
#pragma unroll
            for (int q = 0; q < 4; ++q) { const f32x4 l4 = *(const LAS f32x4*)(LM + (16 * a + c) * 68 + 16 * a + q * 4); Lr[4 * q] = l4[0]; Lr[4 * q + 1] = l4[1]; Lr[4 * q + 2] = l4[2]; Lr[4 * q + 3] = l4[3]; }
            float tc[16];
#pragma unroll
            for (int i = 0; i < 16; ++i) {
                float s = (i == c) ? 1.f : 0.f;
#pragma unroll
                for (int j = 0; j < i; ++j) s -= __int_as_float(__builtin_amdgcn_readlane(__float_as_int(Lr[j]), i)) * tc[j];
                tc[i] = s;
                if (lane < 16) { TF[(16 * a + i) * 68 + 16 * a + c] = s; TB[(16 * a + i) * 72 + 16 * a + c] = f2bf(s); }
            }
        }
        __syncthreads();
        if (w < 3) tri_block(LM, TF, TB, scr, w + 1, w, lane);
        __syncthreads();
        if (w < 2) tri_block(LM, TF, TB, scr, w + 2, w, lane);
        __syncthreads();
        if (w == 0) tri_block(LM, TF, TB, scr, 3, 0, lane);
        __syncthreads();
#ifdef P2_CHECK
        if (w == 0) {
            LAS float* T2 = (LAS float*)(F.lds + Q2_AST);
            float md = 0.f;
            for (int i = 0; i < 64; ++i) {
                float s = (i == lane) ? 1.f : 0.f;
                for (int j = 0; j < i; ++j) s -= LM[i * 68 + j] * T2[j * 65 + lane];
                T2[i * 65 + lane] = s;
                if (i >= lane) md = fmaxf(md, fabsf(s - TF[i * 68 + lane]));
            }
#pragma unroll
            for (int o = 1; o < 64; o <<= 1) md = fmaxf(md, __shfl_xor(md, o));
            if (lane == 0) atomicMax((unsigned*)(F.ws + 64), __float_as_uint(md));
        }
        __syncthreads();
#endif
        {
            f32x4 au[4], aw[4];
#pragma unroll
            for (int mi = 0; mi < 4; ++mi) { au[mi] = (f32x4){0.f, 0.f, 0.f, 0.f}; aw[mi] = (f32x4){0.f, 0.f, 0.f, 0.f}; }
#pragma unroll
            for (int k0 = 0; k0 < 64; k0 += 32) { const bf16x8 bv = ldfrag_swz(VBT, w * 16, k0, lane), bk = ldfrag_swz(KBGT, w * 16, k0, lane);
#pragma unroll
                for (int mi = 0; mi < 4; ++mi) { const bf16x8 a = ldfrag(TB, 72, mi * 16, k0, lane); au[mi] = mfma16(a, bv, au[mi]); aw[mi] = mfma16(a, bk, aw[mi]); } }
            const int cl = w * 16 + (lane & 15);
#pragma unroll
            for (int mi = 0; mi < 4; ++mi)
#pragma unroll
                for (int r = 0; r < 4; ++r) { const int i = mi * 16 + (lane >> 4) * 4 + r; QN[i * 136 + cl] = f2bf(au[mi][r]); KN[i * 136 + cl] = f2bf(aw[mi][r]); }
        }
        __syncthreads();
#pragma unroll
        for (int q = tid; q < 1024; q += NTHREADS) { const int row = q >> 4, ch = q & 15;
            *(u32x4*)(O.uo + (tr0 + row) * O.ld + h * 128 + ch * 8) = *(const LAS u32x4*)(QN + row * 136 + ch * 8);
            *(u32x4*)(O.wo + (tr0 + row) * DM + h * 128 + ch * 8) = *(const LAS u32x4*)(KN + row * 136 + ch * 8); }
        P2_TBL_FINISH();
    }
#pragma unroll 1
    while (tb_it < TB_N) { P2_TBL_ISSUE(); P2_TBL_FINISH(); }
#undef P2_TBL_ISSUE
#undef P2_TBL_FINISH
#undef P2_LOAD
}

constexpr int P3_WC = 0, P3_QGC = 17408, P3_UC = 34816  , P3_KDT = 39936  , P3_AC = 72704  , P3_SBT = 91136, P3_VNT = 99840, P3_OT = 104448  ;
__device__ __forceinline__ void p3_scan(Frame& F) {
    F.fresh();
    bf16_t* PROJ = (bf16_t*)(F.ws + WS_PROJ); const bf16_t* WBUF = (const bf16_t*)(F.ws + WS_WBUF); const bf16_t* ABUF = (const bf16_t*)(F.ws + WS_ABUF); const float* GC = (const float*)(F.ws + WS_GC);
    LAS bf16_t* WC = (LAS bf16_t*)(F.lds + P3_WC); LAS bf16_t* QGC = (LAS bf16_t*)(F.lds + P3_QGC); LAS bf16_t* UC = (LAS bf16_t*)(F.lds + P3_UC);
    LAS bf16_t* SBT = (LAS bf16_t*)(F.lds + P3_SBT); LAS bf16_t* VNT = (LAS bf16_t*)(F.lds + P3_VNT); LAS bf16_t* OT = (LAS bf16_t*)(F.lds + P3_OT);
    const int tid = F.tid, lane = F.lane, w = F.wave;
    for (int u = F.vcu; u < NBATCH * 8 * 4; u += F.G) {
        const int sl = u & 3, h = (u >> 2) & 7, b = u >> 5;
        __syncthreads();
        for (int i = tid; i < 32 * 136; i += NTHREADS) SBT[i] = 0;
        f32x4 accS[2]; accS[0] = (f32x4){0.f, 0.f, 0.f, 0.f}; accS[1] = (f32x4){0.f, 0.f, 0.f, 0.f};
        const int r0 = tid >> 4, c0 = tid & 15;
        const int ra = tid >> 3, ca = tid & 7;
        const int ru = (tid & 255) >> 2, cu = tid & 3;
        u32x4 pw[2][2], pq[2][2], pa[2], pu[2]; u32x2 pk[2][4]; float pgl[2];
        const int kc4 = tid & 31, krg = tid >> 5;
#define P3_LOAD_A(nn, S) do { const size_t tt0 = (size_t)b * SEQ + (size_t)(nn) * 64; \
            _Pragma("unroll") for (int k = 0; k < 2; ++k) { const size_t row = tt0 + r0 + 32 * k; \
                pw[S][k] = *(const u32x4*)(WBUF + row * DM + h * 128 + c0 * 8); pq[S][k] = *(const u32x4*)(PROJ + row * P1N + C_Q + h * 128 + c0 * 8); } } while (0)
#define P3_LOAD_B(nn, S) do { const size_t tt0 = (size_t)b * SEQ + (size_t)(nn) * 64; \
            _Pragma("unroll") for (int k = 0; k < 4; ++k) pk[S][k] = *(const u32x2*)(PROJ + (tt0 + 4 * krg + k) * P1N + C_K + h * 128 + kc4 * 4); } while (0)
#define P3_LOAD_C(nn, S) do { const size_t tt0 = (size_t)b * SEQ + (size_t)(nn) * 64; \
            pa[S] = *(const u32x4*)(ABUF + ((size_t)(b * NCHUNK + (nn)) * 8 + h) * 4096 + ra * 64 + ca * 8); \
            if (tid < 256) pu[S] = *(const u32x4*)(PROJ + (tt0 + ru) * P1N + C_V + h * 128 + sl * 32 + cu * 8); \
            pgl[S] = GC[(tt0 + 63) * 8 + h]; } while (0)
#define P3_LOAD(nn, S) do { P3_LOAD_A(nn, S); P3_LOAD_B(nn, S); P3_LOAD_C(nn, S); } while (0)
#define P3_FILL(bufi, S) do { LAS bf16_t* KDTn = (LAS bf16_t*)(F.lds + P3_KDT + (bufi) * 16384); LAS bf16_t* ACn = (LAS bf16_t*)(F.lds + P3_AC + (bufi) * 9216); \
            _Pragma("unroll") for (int k = 0; k < 2; ++k) { const int row = r0 + 32 * k; \
                *(LAS u32x4*)(WC + row * 136 + c0 * 8) = pw[S][k]; *(LAS u32x4*)(QGC + row * 136 + c0 * 8) = pq[S][k]; } \
            _Pragma("unroll") for (int i = 0; i < 4; ++i) { const int d_ = 4 * kc4 + i; \
                const unsigned v0 = (i < 2 ? pk[S][0].x : pk[S][0].y) >> (16 * (i & 1)), v1 = (i < 2 ? pk[S][1].x : pk[S][1].y) >> (16 * (i & 1)), v2 = (i < 2 ? pk[S][2].x : pk[S][2].y) >> (16 * (i & 1)), v3 = (i < 2 ? pk[S][3].x : pk[S][3].y) >> (16 * (i & 1)); \
                u32x2 o_; o_.x = (v0 & 0xffffu) | (v1 << 16); o_.y = (v2 & 0xffffu) | (v3 << 16); \
                *(LAS u32x2*)(KDTn + d_ * 64 + (((krg >> 1) ^ swz8(d_)) * 8) + 4 * (krg & 1)) = o_; } \
            *(LAS u32x4*)(ACn + ra * 72 + ca * 8) = pa[S]; \
            if (tid < 256) *(LAS u32x4*)(UC + ru * 40 + cu * 8) = pu[S]; } while (0)
#define P3_STEP(n_, cur_) do { const int n = (n_); \
            const size_t t0 = (size_t)b * SEQ + (size_t)n * 64; \
            const LAS bf16_t* KDT = (const LAS bf16_t*)(F.lds + P3_KDT + (cur_) * 16384); const LAS bf16_t* AC = (const LAS bf16_t*)(F.lds + P3_AC + (cur_) * 9216); \
            if (n >= 1 && tid < 256) *(u32x4*)(PROJ + (t0 - 64 + ru) * P1N + C_V + h * 128 + sl * 32 + cu * 8) = *(const LAS u32x4*)(OT + ru * 40 + cu * 8); \
              \
            const int mi = w >> 1, ni = w & 1; \
            f32x4 ax = (f32x4){0.f, 0.f, 0.f, 0.f}, ay = (f32x4){0.f, 0.f, 0.f, 0.f}; \
            _Pragma("unroll") for (int k0 = 0; k0 < 128; k0 += 32) { const bf16x8 bs = ldfrag(SBT, 136, ni * 16, k0, lane); \
                ax = mfma16(ldfrag(WC, 136, mi * 16, k0, lane), bs, ax); ay = mfma16(ldfrag(QGC, 136, mi * 16, k0, lane), bs, ay); } \
            const int e = ni * 16 + (lane & 15); \
            _Pragma("unroll") for (int r = 0; r < 4; ++r) { const int i = mi * 16 + (lane >> 4) * 4 + r; VNT[e * 72 + i] = f2bf(bf2f(UC[i * 40 + e]) - ax[r]); } \
            __builtin_amdgcn_sched_barrier(0); \
            if (n >= 1 && n + 2 < NCHUNK) P3_LOAD_B(n + 2, (cur_)); \
            __syncthreads();                                                     \
            float egl_next = egl; \
            if (n + 1 < NCHUNK) { P3_FILL((cur_) ^ 1, (cur_) ^ 1); egl_next = __expf(pgl[(cur_) ^ 1]); }    \
              \
            _Pragma("unroll") for (int k0 = 0; k0 < 64; k0 += 32) ay = mfma16(ldfrag(AC, 72, mi * 16, k0, lane), ldfrag(VNT, 72, ni * 16, k0, lane), ay); \
            _Pragma("unroll") for (int r = 0; r < 4; ++r) { const int i = mi * 16 + (lane >> 4) * 4 + r; OT[i * 40 + e] = f2bf(ay[r]); }     \
              \
            _Pragma("unroll") for (int mt = 0; mt < 2; ++mt) { accS[mt] = accS[mt] * egl; \
                _Pragma("unroll") for (int k0 = 0; k0 < 64; k0 += 32) accS[mt] = mfma16(ldfrag(VNT, 72, mt * 16, k0, lane), ldfrag_swz(KDT, w * 16, k0, lane), accS[mt]); \
                _Pragma("unroll") for (int r = 0; r < 4; ++r) SBT[(mt * 16 + (lane >> 4) * 4 + r) * 136 + w * 16 + (lane & 15)] = f2bf(accS[mt][r]); } \
              \
            __builtin_amdgcn_sched_barrier(0); \
            if (n + 3 < NCHUNK) { P3_LOAD_A(n + 3, (cur_) ^ 1); P3_LOAD_C(n + 3, (cur_) ^ 1); } \
            egl = egl_next; \
            __syncthreads();                                                     \
        } while (0)
        P3_LOAD(0, 0);
        P3_FILL(0, 0);
        float egl = __expf(pgl[0]);
        __syncthreads();
        P3_LOAD(1, 1); P3_LOAD(2, 0);
#pragma unroll 1
        for (int n2 = 0; n2 < NCHUNK; n2 += 2) { P3_STEP(n2, 0); P3_STEP(n2 + 1, 1); }
        if (tid < 256) *(u32x4*)(PROJ + ((size_t)b * SEQ + (size_t)(NCHUNK - 1) * 64 + ru) * P1N + C_V + h * 128 + sl * 32 + cu * 8) = *(const LAS u32x4*)(OT + ru * 40 + cu * 8);
#undef P3_STEP
#undef P3_LOAD
#undef P3_LOAD_A
#undef P3_LOAD_B
#undef P3_LOAD_C
#undef P3_FILL
    }
}

__device__ __forceinline__ void p4_gated_norm(Frame& F) {
    F.fresh();
    bf16_t* PROJ = (bf16_t*)(F.ws + WS_PROJ);
    const int gt = F.vcu * NTHREADS + F.tid, NGT = F.G * NTHREADS;
    const int sub = F.lane & 15;
    float nw[8];
    { const f32x4 a = *(const f32x4*)(F.dn_norm_w + sub * 8), bq = *(const f32x4*)(F.dn_norm_w + sub * 8 + 4); nw[0] = a[0]; nw[1] = a[1]; nw[2] = a[2]; nw[3] = a[3]; nw[4] = bq[0]; nw[5] = bq[1]; nw[6] = bq[2]; nw[7] = bq[3]; }
    for (int i = gt; i < NTOK * 8 * 16; i += NGT) {
        const int th = i >> 4; const int t = th >> 3, h = th & 7;
        bf16_t* po = PROJ + (size_t)t * P1N + C_V + h * 128 + sub * 8; const bf16_t* pz = PROJ + (size_t)t * P1N + C_Z + h * 128 + sub * 8;
        float o[8], z[8]; unpack8(*(const u32x4*)po, o); unpack8(*(const u32x4*)pz, z);
        float s = 0.f;
#pragma unroll
        for (int k = 0; k < 8; ++k) s += o[k] * o[k];
        s += __shfl_xor(s, 1); s += __shfl_xor(s, 2); s += __shfl_xor(s, 4); s += __shfl_xor(s, 8);
        const float rstd = __builtin_amdgcn_rsqf(s * (1.f / 128.f) + EPS);
#pragma unroll
        for (int k = 0; k < 8; ++k) { const float zz = z[k]; o[k] = o[k] * rstd * nw[k] * (zz * __builtin_amdgcn_rcpf(1.0f + __expf(-zz))); }
        { const unsigned v0 = pack4_fp8(o[0], o[1], o[2], o[3], ON8_SCALE), v1 = pack4_fp8(o[4], o[5], o[6], o[7], ON8_SCALE);
          u32x2 o8; o8.x = v0; o8.y = v1; *(u32x2*)((unsigned char*)F.out + (size_t)t * DM + h * 128 + sub * 8) = o8; }
    }
}

typedef float f32x2v __attribute__((ext_vector_type(2)));
typedef unsigned u32x2v __attribute__((ext_vector_type(2)));
constexpr int P10_KS = 0  , P10_WV = 69632  , P10_LV = 0  , P10_LI = 2304  ,
              P10_OV = 4608  , P10_OC = 5888  , P10_WVSZ = 7168;
template <int CTRL> __device__ __forceinline__ int dpp_i(int v) { return __builtin_amdgcn_update_dpp(0, v, CTRL, 0xF, 0xF, false); }
__device__ __forceinline__ float gmax16(float m) { m = fmaxf(m, __int_as_float(dpp_i<0xB1>(__float_as_int(m)))); m = fmaxf(m, __int_as_float(dpp_i<0x4E>(__float_as_int(m))));
    m = fmaxf(m, __int_as_float(dpp_i<0x141>(__float_as_int(m)))); m = fmaxf(m, __int_as_float(dpp_i<0x140>(__float_as_int(m)))); return m; }
__device__ __forceinline__ float gsumf16(float s) { s += __int_as_float(dpp_i<0xB1>(__float_as_int(s))); s += __int_as_float(dpp_i<0x4E>(__float_as_int(s)));
    s += __int_as_float(dpp_i<0x141>(__float_as_int(s))); s += __int_as_float(dpp_i<0x140>(__float_as_int(s))); return s; }
__device__ __forceinline__ float q4sum(float x) { u32x2v r = __builtin_amdgcn_permlane32_swap(__float_as_uint(x), __float_as_uint(x), false, false); x = __uint_as_float(r[0]) + __uint_as_float(r[1]);
    r = __builtin_amdgcn_permlane16_swap(__float_as_uint(x), __float_as_uint(x), false, false); return __uint_as_float(r[0]) + __uint_as_float(r[1]); }
__device__ __forceinline__ float q4max(float x) { u32x2v r = __builtin_amdgcn_permlane32_swap(__float_as_uint(x), __float_as_uint(x), false, false); x = fmaxf(__uint_as_float(r[0]), __uint_as_float(r[1]));
    r = __builtin_amdgcn_permlane16_swap(__float_as_uint(x), __float_as_uint(x), false, false); return fmaxf(__uint_as_float(r[0]), __uint_as_float(r[1])); }
__device__ __forceinline__ float q4min(float x) { u32x2v r = __builtin_amdgcn_permlane32_swap(__float_as_uint(x), __float_as_uint(x), false, false); x = fminf(__uint_as_float(r[0]), __uint_as_float(r[1]));
    r = __builtin_amdgcn_permlane16_swap(__float_as_uint(x), __float_as_uint(x), false, false); return fminf(__uint_as_float(r[0]), __uint_as_float(r[1])); }
__device__ __forceinline__ int q4prefix(int x, int g) { const int x1 = __shfl_xor(x, 16), x2 = __shfl_xor(x, 32), x3 = __shfl_xor(x, 48); return ((g & 1) ? x1 : 0) + ((g & 2) ? x2 + x3 : 0); }
__device__ __forceinline__ int q4total(int x) { return x + __shfl_xor(x, 16) + __shfl_xor(x, 32) + __shfl_xor(x, 48); }
__device__ __forceinline__ f32x2v pk_above(f32x2v v, f32x2v big, f32x2v nmid) { f32x2v r; asm("v_pk_fma_f32 %0, %1, %2, %3 clamp" : "=v"(r) : "v"(v), "v"(big), "v"(nmid)); return r; }
constexpr float P10_BIG = 0x1p100f;
template <int NP> __device__ __forceinline__ float p10_count(const f32x2v (&V)[NP], float mid) {
    const f32x2v big = {P10_BIG, P10_BIG}; const float nm = -mid * P10_BIG; const f32x2v nmid = {nm, nm};
    f32x2v a = {0.f, 0.f}, b = {0.f, 0.f};
#pragma unroll
    for (int i = 0; i < NP; i += 2) { a += pk_above(V[i], big, nmid); b += pk_above(V[i + 1], big, nmid); }
    const f32x2v s = a + b; return s[0] + s[1];
}
template <int STAGE> __device__ __forceinline__ constexpr int p10_code(int i, int e) { return STAGE == 1 ? 16 * (i >> 1) + 2 * (i & 1) + e : 2 * i + e; }
template <int NP, int STAGE> __device__ __forceinline__ void p10_emit_fast(const f32x2v (&V)[NP], float thr, unsigned pos, unsigned dump, LAS unsigned char* vb, LAS unsigned char* ib, int code0) {
#pragma unroll
    for (int i = 0; i < NP; ++i)
#pragma unroll
        for (int e = 0; e < 2; ++e) { const float val = V[i][e]; const bool c = val > thr; const unsigned a = c ? pos : dump;
            *(LAS float*)(vb + a) = val; *(LAS int*)(ib + a) = code0 | p10_code<STAGE>(i, e); pos += c ? 4u : 0u; __builtin_amdgcn_sched_barrier(0); }
}
template <int NP, int STAGE> __device__ __forceinline__ void p10_emit_general(const f32x2v (&V)[NP], float lo, float hi, int g, unsigned lb, unsigned dump, LAS unsigned char* vb, LAS unsigned char* ib, int code0) {
    int na = 0, nt = 0;
#pragma unroll
    for (int i = 0; i < NP; ++i)
#pragma unroll
        for (int e = 0; e < 2; ++e) { const float val = V[i][e]; const bool a = val > hi, t = (val > lo) && !a; na += a ? 1 : 0; nt += t ? 1 : 0; __builtin_amdgcn_sched_barrier(0); }
    const int H = q4total(na), tpre = q4prefix(nt, g);
    const int take = min(nt, max(0, 16 - H - tpre));
    const int base = q4prefix(na + take, g);
    unsigned pos = lb + 4u * (unsigned)base; int trank = 0;
    asm volatile("" : "+v"(lo), "+v"(hi));
#pragma unroll
    for (int i = 0; i < NP; ++i)
#pragma unroll
        for (int e = 0; e < 2; ++e) { const float val = V[i][e]; const bool a = val > hi, t = (val > lo) && !a; const bool c = a || (t && trank < take); trank += t ? 1 : 0;
            const unsigned ad = c ? pos : dump; *(LAS float*)(vb + ad) = val; *(LAS int*)(ib + ad) = code0 | p10_code<STAGE>(i, e); pos += c ? 4u : 0u; __builtin_amdgcn_sched_barrier(0); }
}
__device__ __forceinline__ void p10_topk(Frame& F) {
    F.fresh();
    const bf16_t* Q2 = (const bf16_t*)(F.ws + WS_Q2); const bf16_t* KEYS = (const bf16_t*)(F.ws + WS_KEYS); int* IDX = (int*)(F.ws + WS_IDX); float* GATEW = (float*)(F.ws + WS_GATEW);
    LAS bf16_t* KS = (LAS bf16_t*)(F.lds + P10_KS);
    const int tid = F.tid, lane = F.lane, w = F.wave, tok = lane & 15, g = lane >> 4;
    LAS unsigned char* WV = F.lds + P10_WV + w * P10_WVSZ;
    LAS unsigned char* LVb = WV + P10_LV; LAS unsigned char* LIb = WV + P10_LI; LAS unsigned char* OVb = WV + P10_OV; LAS unsigned char* OCb = WV + P10_OC;
    const int NSU = (NTOK / 256) * 8;
    int cur_h = -1;
    bf16x8 qf[2][4];
#define P10_LOADQ(su_, j_) do { const bf16_t* qp_ = Q2 + (size_t)(((su_) >> 3) * 256 + (2 * w + (j_)) * 16 + tok) * 2048 + ((su_) & 7) * 256 + 8 * g; \
        _Pragma("unroll") for (int p_ = 0; p_ < 2; ++p_) _Pragma("unroll") for (int ks_ = 0; ks_ < 4; ++ks_) qf[p_][ks_] = *(const bf16x8*)(qp_ + p_ * 128 + ks_ * 32); } while (0)
    int su = F.vcu;
    if (su < NSU) P10_LOADQ(su, 0);
#pragma unroll 1
    for (; su < NSU; su += F.G) {
        const int h = su & 7, t0 = (su >> 3) * 256;
        if (h != cur_h) {
            __syncthreads();
            for (int q = tid; q < 4096; q += NTHREADS) { const int row = q >> 4, cc = q & 15; *(LAS u32x4*)(KS + row * 136 + cc * 8) = *(const u32x4*)(KEYS + (size_t)h * 32768 + row * 128 + cc * 8); }
            cur_h = h;
            __syncthreads();
        }
#pragma unroll 1
        for (int j = 0; j < 2; ++j) {
            const int tb = t0 + (2 * w + j) * 16;
            f32x2v V0[16], V1[16];
            {
                f32x4 acc[2][8];
#pragma unroll
                for (int p = 0; p < 2; ++p)
#pragma unroll
                    for (int kt = 0; kt < 8; ++kt) acc[p][kt] = (f32x4){0.f, 0.f, 0.f, 0.f};
#pragma unroll
                for (int p = 0; p < 2; ++p)
#pragma unroll
                    for (int ks = 0; ks < 4; ++ks)
#pragma unroll
                        for (int kt = 0; kt < 8; ++kt) acc[p][kt] = mfma16(ldfrag(KS, 136, p * 128 + kt * 16, ks * 32, lane), qf[p][ks], acc[p][kt]);
#pragma unroll
                for (int kt = 0; kt < 8; ++kt)
#pragma unroll
                    for (int hh = 0; hh < 2; ++hh) { const float a0 = acc[0][kt][2 * hh], a1 = acc[0][kt][2 * hh + 1], b0 = acc[1][kt][2 * hh], b1 = acc[1][kt][2 * hh + 1];
                        V0[2 * kt + hh] = (f32x2v){fabsf(a0) < 0x1p-60f ? 0.f : a0, fabsf(a1) < 0x1p-60f ? 0.f : a1};
                        V1[2 * kt + hh] = (f32x2v){fabsf(b0) < 0x1p-60f ? 0.f : b0, fabsf(b1) < 0x1p-60f ? 0.f : b1}; __builtin_amdgcn_sched_barrier(0); }
            }
            {
                const int nsu = (j == 0) ? su : su + F.G;
                if (nsu < NSU) P10_LOADQ(nsu, j ^ 1);
            }
            float gmx0, gmx1, lo0, lo1, hi0, hi1, n0 = 0.f, n1 = 0.f;
            { float mx0 = V0[0][0], mn0 = V0[0][0], mx1 = V1[0][0], mn1 = V1[0][0];
#pragma unroll
              for (int i = 0; i < 16; ++i)
#pragma unroll
                  for (int e = 0; e < 2; ++e) { mx0 = fmaxf(mx0, V0[i][e]); mn0 = fminf(mn0, V0[i][e]); mx1 = fmaxf(mx1, V1[i][e]); mn1 = fminf(mn1, V1[i][e]); }
              gmx0 = q4max(mx0); gmx1 = q4max(mx1); lo0 = q4min(mn0) - 1.0f; lo1 = q4min(mn1) - 1.0f; hi0 = gmx0; hi1 = gmx1; }
            for (int it = 0; it < 48; ++it) {
                const float m0 = 0.5f * (lo0 + hi0), m1 = 0.5f * (lo1 + hi1);
                n0 = p10_count<16>(V0, m0); n1 = p10_count<16>(V1, m1);
                const float c0 = q4sum(n0), c1 = q4sum(n1);
                lo0 = (c0 >= 16.f) ? m0 : lo0; hi0 = (c0 <= 16.f) ? m0 : hi0; lo1 = (c1 >= 16.f) ? m1 : lo1; hi1 = (c1 <= 16.f) ? m1 : hi1;
                if (__all(lo0 == hi0 && lo1 == hi1)) break;
            }
            const unsigned lb0 = (unsigned)((tok * 2 + 0) * 64), lb1 = (unsigned)((tok * 2 + 1) * 64), dump1 = 2048u + 4u * (unsigned)lane;
            if (__all(lo0 == hi0 && lo1 == hi1)) {
                const int pre = q4prefix((int)n0 | ((int)n1 << 8), g);
                p10_emit_fast<16, 1>(V0, hi0, lb0 + 4u * (unsigned)(pre & 255), dump1, LVb, LIb, 4 * g);
                p10_emit_fast<16, 1>(V1, hi1, lb1 + 4u * (unsigned)(pre >> 8), dump1, LVb, LIb, 4 * g);
            } else {
                p10_emit_general<16, 1>(V0, lo0, hi0, g, lb0, dump1, LVb, LIb, 4 * g);
                p10_emit_general<16, 1>(V1, lo1, hi1, g, lb1, dump1, LVb, LIb, 4 * g);
            }
            LDS_WAIT();
            f32x2v CS[32];
            { const f32x4 v1 = *(const LAS f32x4*)(LVb + lb0 + 16 * g);
#pragma unroll
              for (int k = 0; k < 4; ++k) { const f32x4 v2 = *(const LAS f32x4*)(LVb + lb1 + 16 * k);
#pragma unroll
                  for (int a = 0; a < 4; ++a) { CS[8 * a + 2 * k] = (f32x2v){v1[a] + v2[0], v1[a] + v2[1]}; CS[8 * a + 2 * k + 1] = (f32x2v){v1[a] + v2[2], v1[a] + v2[3]}; } } }
            const float m2 = fmaxf(gmx0 + lo1, gmx1 + lo0);
            float lo2 = (lo0 == hi0 && lo1 == hi1) ? m2 - fmaxf(fabsf(m2) * 1e-6f, 1e-30f) : lo0 + lo1 - 1.0f, hi2 = gmx0 + gmx1, n2 = 0.f;
            for (int it = 0; it < 48; ++it) {
                const float m2 = 0.5f * (lo2 + hi2);
                n2 = p10_count<32>(CS, m2);
                const float c2 = q4sum(n2);
                lo2 = (c2 >= 16.f) ? m2 : lo2; hi2 = (c2 <= 16.f) ? m2 : hi2;
                if (__all(lo2 == hi2)) break;
            }
            const unsigned ob = (unsigned)(tok * 64), dump2 = 1024u + 4u * (unsigned)lane;
            if (__all(lo2 == hi2)) p10_emit_fast<32, 2>(CS, hi2, ob + 4u * (unsigned)q4prefix((int)n2, g), dump2, OVb, OCb, 64 * g);
            else p10_emit_general<32, 2>(CS, lo2, hi2, g, ob, dump2, OVb, OCb, 64 * g);
            LDS_WAIT();
#pragma unroll
            for (int ps = 0; ps < 4; ++ps) { const int tk = 4 * ps + g, q = tok;
                const float vv = *(const LAS float*)(OVb + tk * 64 + q * 4); const int code = *(const LAS int*)(OCb + tk * 64 + q * 4);
                const int i1 = *(const LAS int*)(LIb + (tk * 2) * 64 + (code >> 4) * 4), i2 = *(const LAS int*)(LIb + (tk * 2 + 1) * 64 + (code & 15) * 4);
                const float m = gmax16(vv); const float e = __expf(vv - m); const float sum = gsumf16(e);
                const size_t o = (size_t)(tb + tk) * 128 + h * 16 + q; IDX[o] = i1 * 128 + i2; GATEW[o] = e * __builtin_amdgcn_rcpf(sum); }
            LDS_WAIT();
        }
    }
#undef P10_LOADQ
}

constexpr size_t WS_PD = WS_PROJ, WS_COEF = WS_PROJ + 320 * MiB, WS_SSQ2 = WS_PROJ + 352 * MiB;
__device__ __forceinline__ void fp8x16_to_f32(const u32x4 r, float* f) {
    const unsigned w[4] = {r.x, r.y, r.z, r.w};
#pragma unroll
    for (int i = 0; i < 4; ++i) { const f32x2v a = __builtin_amdgcn_cvt_pk_f32_fp8((int)w[i], false), bq = __builtin_amdgcn_cvt_pk_f32_fp8((int)w[i], true); f[4 * i] = a[0]; f[4 * i + 1] = a[1]; f[4 * i + 2] = bq[0]; f[4 * i + 3] = bq[1]; }
}
__device__ __forceinline__ float gelu_erf(float v) {
    const float av = fabsf(v), t = __builtin_amdgcn_rcpf(av * 0.2316418882f + 1.0f);
    float q = t * 0.5307027145f + (-0.7265760135f); q = q * t + 0.7107068705f; q = q * t + (-0.142248368f); q = q * t + 0.127414796f; q = q * t;
    const float e = __builtin_amdgcn_exp2f((v * v) * (-0.72134752044f));
    const float m = v * (q * e);
    return v < 0.f ? m : v - m;
}
__device__ __forceinline__ void fp8x16_to_f32x2(const u32x4 r, f32x2v* f2) {
    const unsigned w[4] = {r.x, r.y, r.z, r.w};
#pragma unroll
    for (int i = 0; i < 4; ++i) { f2[2 * i] = __builtin_amdgcn_cvt_pk_f32_fp8((int)w[i], false); f2[2 * i + 1] = __builtin_amdgcn_cvt_pk_f32_fp8((int)w[i], true); }
}
__device__ __forceinline__ float gsumf8(float s) { s += dpp_f<0xB1>(s); s += dpp_f<0x4E>(s); s += dpp_f<0x141>(s); return s; }
__device__ __forceinline__ int ld_i32(const void* base, unsigned boff) { return *(const int*)((const char*)base + boff); }
__device__ __forceinline__ float ld_f32(const void* base, unsigned boff) { return *(const float*)((const char*)base + boff); }
__device__ __forceinline__ u32x4 ld_u32x4(const void* base, unsigned boff) { return *(const u32x4*)((const char*)base + boff); }
template <int MODE> __device__ __forceinline__ void p11a_down(Frame& F) {
    F.fresh();
    const bf16_t* HB = (const bf16_t*)(F.ws + WS_WBUF); const int* IDX = (const int*)(F.ws + WS_IDX); const unsigned char* ED = (const unsigned char*)(F.ws + WS_EDOWN); bf16_t* PD = (bf16_t*)(F.ws + WS_PD);
    const int lane = F.lane, w = F.wave, r = lane >> 3, c = lane & 7;
    const int bps = F.sl_n, s = F.sl_s, rk = F.sl_rk;
    const int tpw = NTOK / (bps * NWAVES);
    const size_t tbeg = ((size_t)rk * NWAVES + w) * tpw;
    const unsigned char* EDb = ED + (size_t)s * (16384 * 128);
    const unsigned coff = 16u * (unsigned)c;
    u32x4 q0[8], q1[8], q2[8], q3[8]; int enA[16], enB[16];
    LAS unsigned char* ST = F.lds + w * 4096;
    u32x4 sti[2];
    const int nblk = tpw / 4;
#define P11A_BLK_LOAD(bb) do { const size_t tb_ = tbeg + (size_t)(bb) * 4; _Pragma("unroll") for (int j = 0; j < 2; ++j) sti[j] = *(const u32x4*)((const unsigned char*)IDX + tb_ * 512 + 1024 * j + 16 * lane); } while (0)
#define P11A_BLK_STORE(bb) do { LAS unsigned char* d_ = ST + ((bb) & 1) * 2048; _Pragma("unroll") for (int j = 0; j < 2; ++j) *(LAS u32x4*)(d_ + 1024 * j + 16 * lane) = sti[j]; } while (0)
#define P11A_IDS(en, tt) do { const int tj_ = (int)((tt) - tbeg); const LAS unsigned char* tp_ = ST + ((tj_ >> 2) & 1) * 2048 + (tj_ & 3) * 512 + 64 * r; \
        _Pragma("unroll") for (int q = 0; q < 4; ++q) { const u32x4 e4_ = *(const LAS u32x4*)(tp_ + 16 * q); en[4 * q] = (int)e4_.x; en[4 * q + 1] = (int)e4_.y; en[4 * q + 2] = (int)e4_.z; en[4 * q + 3] = (int)e4_.w; } } while (0)
#define P11A_LOAD(buf, en, h8) do { _Pragma("unroll") for (int i = 0; i < 8; ++i) buf[i] = ld_u32x4(EDb, (MODE == 2 ? ((unsigned)en[(h8) + i] & 1u) : (unsigned)en[(h8) + i]) * 128u + coff); } while (0)
#define P11A_DOTS(buf, koff) do { if (MODE == 1) { unsigned x_ = 0; _Pragma("unroll") for (int i = 0; i < 8; ++i) x_ ^= buf[i].x ^ buf[i].y ^ buf[i].z ^ buf[i].w; if (c == 0) pd[(koff)] = (bf16_t)(x_ & 0xffffu); } \
        else { float p_[8]; \
            _Pragma("unroll") for (int i = 0; i < 8; ++i) { f32x2v f2[8]; fp8x16_to_f32x2(buf[i], f2); f32x2v d0 = {0.f, 0.f}, d1 = {0.f, 0.f}; \
                _Pragma("unroll") for (int k = 0; k < 4; ++k) { d0 = __builtin_elementwise_fma(hv[k], f2[k], d0); d1 = __builtin_elementwise_fma(hv[4 + k], f2[4 + k], d1); } \
                const f32x2v dd = d0 + d1; p_[i] = dd[0] + dd[1]; } \
              \
            float q4_[4], q2_[2]; \
            _Pragma("unroll") for (int k = 0; k < 4; ++k) { const float keep = cb0 ? p_[4 + k] : p_[k], send = cb0 ? p_[k] : p_[4 + k]; q4_[k] = keep + dpp_f<0xB1>(send); } \
            _Pragma("unroll") for (int k = 0; k < 2; ++k) { const float keep = cb1 ? q4_[2 + k] : q4_[k], send = cb1 ? q4_[k] : q4_[2 + k]; q2_[k] = keep + dpp_f<0x4E>(send); } \
            { const float keep = cb2 ? q2_[1] : q2_[0], send = cb2 ? q2_[0] : q2_[1]; \
              pd[(koff) + crow] = f2bf(keep + __int_as_float(__builtin_amdgcn_ds_swizzle(__float_as_int(send), 0x101F))); } } } while (0)
#define P11A_HV(tt) do { float a[8], bq[8]; unpack8(*(const u32x4*)(HBs + (tt) * DM), a); unpack8(*(const u32x4*)(HBs + (tt) * DM + 8), bq); \
        _Pragma("unroll") for (int i = 0; i < 4; ++i) { hv[i] = (f32x2v){a[2 * i], a[2 * i + 1]}; hv[4 + i] = (f32x2v){bq[2 * i], bq[2 * i + 1]}; } } while (0)
    const bf16_t* HBs = HB + 128 * s + 16 * c;
    const bool cb0 = c & 1, cb1 = c & 2, cb2 = c & 4; const int crow = ((c & 1) << 2) | (c & 2) | ((c & 4) >> 2);
    const size_t tlast = tbeg + tpw - 1;
#define P11A_CLAMP(x) (((x) <= tlast) ? (x) : tlast)
    P11A_BLK_LOAD(0); P11A_BLK_STORE(0);
    if (nblk > 1) P11A_BLK_LOAD(1);
    LDS_WAIT();
    P11A_IDS(enA, tbeg); P11A_IDS(enB, tbeg + 1);
    P11A_LOAD(q0, enA, 0); P11A_LOAD(q1, enA, 8); P11A_LOAD(q2, enB, 0); P11A_LOAD(q3, enB, 8);
    P11A_IDS(enA, P11A_CLAMP(tbeg + 2)); P11A_IDS(enB, P11A_CLAMP(tbeg + 3));
#pragma unroll 1
    for (int ti = 0; ti < tpw; ti += 2) {
        const size_t t = tbeg + ti;
        if ((ti & 3) == 0) { const int bb = ti >> 2; if (bb + 1 < nblk) P11A_BLK_STORE(bb + 1); if (bb + 2 < nblk) P11A_BLK_LOAD(bb + 2); }
        f32x2v hv[8];
        { P11A_HV(t); bf16_t* pd = PD + ((size_t)s * NTOK + t) * 128 + 16 * r;
          P11A_DOTS(q0, 0); P11A_LOAD(q0, enA, 0);
          P11A_DOTS(q1, 8); P11A_LOAD(q1, enA, 8); }
        P11A_IDS(enA, P11A_CLAMP(t + 4));
        { P11A_HV(t + 1); bf16_t* pd = PD + ((size_t)s * NTOK + t + 1) * 128 + 16 * r;
          P11A_DOTS(q2, 0); P11A_LOAD(q2, enB, 0);
          P11A_DOTS(q3, 8); P11A_LOAD(q3, enB, 8); }
        P11A_IDS(enB, P11A_CLAMP(t + 5));
    }
#undef P11A_IDS
#undef P11A_BLK_LOAD
#undef P11A_BLK_STORE
#undef P11A_LOAD
#undef P11A_DOTS
#undef P11A_HV
#undef P11A_CLAMP
}
__device__ __forceinline__ void p11b_coef(Frame& F) {
    F.fresh();
    const bf16_t* PD = (const bf16_t*)(F.ws + WS_PD); const float* SSQ = (const float*)(F.ws + WS_SSQ); const float* GATEW = (const float*)(F.ws + WS_GATEW); float* CF = (float*)(F.ws + WS_COEF);
    const size_t gt = (size_t)F.vcu * NTHREADS + F.tid, NGT = (size_t)F.G * NTHREADS;
    for (size_t i = gt; i < (size_t)NTOK * 16; i += NGT) {
        const size_t t = i >> 4; const int k8 = (int)(i & 15) * 8;
        float acc[8];
        unpack8(*(const u32x4*)(PD + t * 128 + k8), acc);
#pragma unroll
        for (int s = 1; s < 8; ++s) { float p[8]; unpack8(*(const u32x4*)(PD + ((size_t)s * NTOK + t) * 128 + k8), p);
#pragma unroll
            for (int e = 0; e < 8; ++e) acc[e] += p[e]; }
        const f32x4* sp = (const f32x4*)(SSQ + t * 16); const f32x4 s4 = (sp[0] + sp[1]) + (sp[2] + sp[3]);
        const float rs = (1.0f / ED_SCALE) * __builtin_amdgcn_rsqf(((s4[0] + s4[1]) + (s4[2] + s4[3])) * (1.f / DM) + EPS);
        const f32x4 g0 = *(const f32x4*)(GATEW + t * 128 + k8), g1 = *(const f32x4*)(GATEW + t * 128 + k8 + 4);
        f32x4 o0, o1;
#pragma unroll
        for (int e = 0; e < 4; ++e) { o0[e] = gelu_erf(acc[e] * rs) * g0[e] * (1.0f / EU_SCALE); o1[e] = gelu_erf(acc[4 + e] * rs) * g1[e] * (1.0f / EU_SCALE); }
        *(f32x4*)(CF + t * 128 + k8) = o0; *(f32x4*)(CF + t * 128 + k8 + 4) = o1;
    }
}
__device__ __forceinline__ void p11c_up(Frame& F) {
    F.fresh();
    const int* IDX = (const int*)(F.ws + WS_IDX); const unsigned char* EU = (const unsigned char*)(F.ws + WS_EUP); const float* CF = (const float*)(F.ws + WS_COEF); float* SSQ2 = (float*)(F.ws + WS_SSQ2); bf16_t* HBr = (bf16_t*)(F.ws + WS_WBUF);
    const int lane = F.lane, w = F.wave, r = lane >> 3, c = lane & 7;
    const int bps = F.sl_n, s = F.sl_s, rk = F.sl_rk;
    const int tpw = NTOK / (bps * NWAVES);
    const size_t tbeg = ((size_t)rk * NWAVES + w) * tpw;
    const unsigned char* EUb = EU + (size_t)s * (16384 * 128);
    const unsigned coff = 16u * (unsigned)c;
    const int r0 = r & 1, r1 = (r >> 1) & 1, r2 = (r >> 2) & 1;
    const int eoff = 8 * r0 + 4 * r1 + 2 * r2;
    LAS unsigned char* ST = F.lds + w * 16384;
    u32x4 sti[4], stc[4];
#define P11C_BLK_LOAD(bb) do { const size_t tb_ = tbeg + (size_t)(bb) * 8; _Pragma("unroll") for (int j = 0; j < 4; ++j) { \
            sti[j] = *(const u32x4*)((const unsigned char*)IDX + tb_ * 512 + 1024 * j + 16 * lane); stc[j] = *(const u32x4*)((const unsigned char*)CF + tb_ * 512 + 1024 * j + 16 * lane); } } while (0)
#define P11C_BLK_STORE(bb) do { LAS unsigned char* d_ = ST + ((bb) & 1) * 8192; _Pragma("unroll") for (int j = 0; j < 4; ++j) { \
            *(LAS u32x4*)(d_ + 1024 * j + 16 * lane) = sti[j]; *(LAS u32x4*)(d_ + 4096 + 1024 * j + 16 * lane) = stc[j]; } } while (0)
#define P11C_TOKP(tj) (ST + (((tj) >> 3) & 1) * 8192 + ((tj) & 7) * 512 + 64 * r)
    const int nblk = tpw / 8;
    P11C_BLK_LOAD(0); P11C_BLK_STORE(0);
    if (nblk > 1) P11C_BLK_LOAD(1);
    LDS_WAIT();
    u32x4 va[8], vb[8]; float ca[8], cb[8];
    { const LAS unsigned char* tp = P11C_TOKP(0);
#pragma unroll
      for (int q = 0; q < 2; ++q) { const u32x4 e4 = *(const LAS u32x4*)(tp + 16 * q); const f32x4 c4 = *(const LAS f32x4*)(tp + 4096 + 16 * q);
          va[4 * q] = ld_u32x4(EUb, e4.x * 128u + coff); va[4 * q + 1] = ld_u32x4(EUb, e4.y * 128u + coff); va[4 * q + 2] = ld_u32x4(EUb, e4.z * 128u + coff); va[4 * q + 3] = ld_u32x4(EUb, e4.w * 128u + coff);
          ca[4 * q] = c4[0]; ca[4 * q + 1] = c4[1]; ca[4 * q + 2] = c4[2]; ca[4 * q + 3] = c4[3]; }
#pragma unroll
      for (int q = 0; q < 2; ++q) { const u32x4 e4 = *(const LAS u32x4*)(tp + 32 + 16 * q); const f32x4 c4 = *(const LAS f32x4*)(tp + 4096 + 32 + 16 * q);
          vb[4 * q] = ld_u32x4(EUb, e4.x * 128u + coff); vb[4 * q + 1] = ld_u32x4(EUb, e4.y * 128u + coff); vb[4 * q + 2] = ld_u32x4(EUb, e4.z * 128u + coff); vb[4 * q + 3] = ld_u32x4(EUb, e4.w * 128u + coff);
          cb[4 * q] = c4[0]; cb[4 * q + 1] = c4[1]; cb[4 * q + 2] = c4[2]; cb[4 * q + 3] = c4[3]; } }
#pragma unroll 1
    for (int ti = 0; ti < tpw; ++ti) {
        const size_t t = tbeg + ti;
        if ((ti & 7) == 0) {
            const int bb = ti >> 3;
            if (bb + 1 < nblk) P11C_BLK_STORE(bb + 1);
            if (bb + 2 < nblk) P11C_BLK_LOAD(bb + 2);
        }
        const int tn = (ti + 1 < tpw) ? ti + 1 : ti;
        const LAS unsigned char* tp = P11C_TOKP(tn);
        u32x4 ea[2], eb[2];
        ea[0] = *(const LAS u32x4*)(tp); ea[1] = *(const LAS u32x4*)(tp + 16); eb[0] = *(const LAS u32x4*)(tp + 32); eb[1] = *(const LAS u32x4*)(tp + 48);
        unsigned* hrow = (unsigned*)(HBr + t * DM + 128 * s + 16 * c + eoff);
        const unsigned hbw = *hrow; const f32x2v hh = {bflo(hbw), bfhi(hbw)};
        f32x2v y2[8];
#pragma unroll
        for (int k = 0; k < 8; ++k) y2[k] = (f32x2v){0.f, 0.f};
#pragma unroll
        for (int i = 0; i < 8; ++i) { f32x2v f2[8]; fp8x16_to_f32x2(va[i], f2); const f32x2v cc2 = {ca[i], ca[i]};
#pragma unroll
            for (int k = 0; k < 8; ++k) y2[k] = __builtin_elementwise_fma(cc2, f2[k], y2[k]);
            }
#pragma unroll
        for (int q = 0; q < 2; ++q) { const f32x4 c4 = *(const LAS f32x4*)(tp + 4096 + 16 * q);
            va[4 * q] = ld_u32x4(EUb, ea[q].x * 128u + coff); va[4 * q + 1] = ld_u32x4(EUb, ea[q].y * 128u + coff); va[4 * q + 2] = ld_u32x4(EUb, ea[q].z * 128u + coff); va[4 * q + 3] = ld_u32x4(EUb, ea[q].w * 128u + coff);
            ca[4 * q] = c4[0]; ca[4 * q + 1] = c4[1]; ca[4 * q + 2] = c4[2]; ca[4 * q + 3] = c4[3]; }
#pragma unroll
        for (int i = 0; i < 8; ++i) { f32x2v f2[8]; fp8x16_to_f32x2(vb[i], f2); const f32x2v cc2 = {cb[i], cb[i]};
#pragma unroll
            for (int k = 0; k < 8; ++k) y2[k] = __builtin_elementwise_fma(cc2, f2[k], y2[k]);
            }
#pragma unroll
        for (int q = 0; q < 2; ++q) { const f32x4 c4 = *(const LAS f32x4*)(tp + 4096 + 32 + 16 * q);
            vb[4 * q] = ld_u32x4(EUb, eb[q].x * 128u + coff); vb[4 * q + 1] = ld_u32x4(EUb, eb[q].y * 128u + coff); vb[4 * q + 2] = ld_u32x4(EUb, eb[q].z * 128u + coff); vb[4 * q + 3] = ld_u32x4(EUb, eb[q].w * 128u + coff);
            cb[4 * q] = c4[0]; cb[4 * q + 1] = c4[1]; cb[4 * q + 2] = c4[2]; cb[4 * q + 3] = c4[3]; }
        float y[16];
#pragma unroll
        for (int k = 0; k < 8; ++k) { y[2 * k] = y2[k][0]; y[2 * k + 1] = y2[k][1]; }
        float y8[8], y4[4], yf[2];
#pragma unroll
        for (int k = 0; k < 8; ++k) { const float keep = r0 ? y[8 + k] : y[k], send = r0 ? y[k] : y[8 + k]; y8[k] = keep + __shfl_xor(send, 8); }
#pragma unroll
        for (int k = 0; k < 4; ++k) { const float keep = r1 ? y8[4 + k] : y8[k], send = r1 ? y8[k] : y8[4 + k]; y4[k] = keep + __shfl_xor(send, 16); }
#pragma unroll
        for (int k = 0; k < 2; ++k) { const float keep = r2 ? y4[2 + k] : y4[k], send = r2 ? y4[k] : y4[2 + k]; yf[k] = keep + __shfl_xor(send, 32); }
        const float z0 = hh[0] + yf[0], z1 = hh[1] + yf[1];
        const unsigned zw = pg8::cvt_pk_bf16(z0, z1); *hrow = zw;
        const float zr0 = bflo(zw), zr1 = bfhi(zw);
        const float ss = wave_sum(zr0 * zr0 + zr1 * zr1);
        if (lane == 0) SSQ2[t * 8 + s] = ss;
    }
#undef P11C_BLK_LOAD
#undef P11C_BLK_STORE
#undef P11C_TOKP
}
__device__ __forceinline__ void p11d_final(Frame& F) {
    F.fresh();
    const float* SSQ2 = (const float*)(F.ws + WS_SSQ2); const bf16_t* Z = (const bf16_t*)(F.ws + WS_WBUF);
    const int gw = F.vcu * NWAVES + F.wave, NGW = F.G * NWAVES, lane = F.lane;
    f32x4 fw[4];
#pragma unroll
    for (int q = 0; q < 4; ++q) fw[q] = *(const f32x4*)(F.final_norm_w + (q >> 1) * 512 + lane * 8 + (q & 1) * 4);
    for (int t = gw; t < NTOK; t += NGW) {
        const f32x4* sp = (const f32x4*)(SSQ2 + (size_t)t * 8); const f32x4 s4 = sp[0] + sp[1];
        const float r2 = 1.0f / sqrtf(((s4[0] + s4[1]) + (s4[2] + s4[3])) * (1.f / DM) + EPS);
        const bf16_t* zrow = Z + (size_t)t * DM; float* row = F.out + (size_t)t * DM;
#pragma unroll
        for (int q = 0; q < 2; ++q) { float z[8]; unpack8(*(const u32x4*)(zrow + q * 512 + lane * 8), z);
            const f32x4 z0 = {z[0], z[1], z[2], z[3]}, z1 = {z[4], z[5], z[6], z[7]};
            *(f32x4*)(row + q * 512 + lane * 8) = z0 * r2 * fw[2 * q]; *(f32x4*)(row + q * 512 + lane * 8 + 4) = z1 * r2 * fw[2 * q + 1]; }
    }
}

#define XB_TMO      128
#define XB_XCNT(j)  (256  + 64 * (j))
#define XB_XSUB(j)  (1280 + 64 * (j))
#define XB_XGEN(j)  (2304 + 64 * (j))
#define XB_TOP      3328
#define XB_TOPGEN   3392
#define XCD_BAR_WORDS 3456
#define XB_SPIN_CAP (1u << 18)

__device__ __forceinline__ unsigned xb_ld(unsigned* p)              { return __hip_atomic_load(p, __ATOMIC_RELAXED, __HIP_MEMORY_SCOPE_AGENT); }
__device__ __forceinline__ unsigned xb_add(unsigned* p, unsigned v) { return __hip_atomic_fetch_add(p, v, __ATOMIC_RELAXED, __HIP_MEMORY_SCOPE_AGENT); }
__device__ __forceinline__ unsigned xb_xcc_id() { return (unsigned)__builtin_amdgcn_s_getreg((3 << 11) | 20) & 0xFu; }
#define XB_SPIN(cond, bar) do { unsigned _sp = 0; while (cond) { __builtin_amdgcn_s_sleep(1); \
    if ((++_sp & 255u) == 0u) { if (xb_ld(&(bar)[XB_TMO])) break; if (_sp > XB_SPIN_CAP) { atomicAdd(&(bar)[XB_TMO], 1u); break; } } } } while (0)

struct XcdBarrier {
    unsigned* bar; unsigned x;
    volatile LAS unsigned* st;
};

__device__ __forceinline__ XcdBarrier xcd_barrier_post(unsigned* bar, volatile LAS unsigned* st) {
    XcdBarrier b; b.bar = bar; b.x = xb_xcc_id(); b.st = st;
    if (threadIdx.x == 0) (void)xb_add(&bar[XB_XCNT(b.x)], 1u);
    return b;
}
__device__ __forceinline__ void xcd_barrier_complete(unsigned* bar, unsigned x, unsigned& nloc, unsigned& nx) {
    const unsigned G = gridDim.x * gridDim.y * gridDim.z;
    unsigned sum, cnt, mine, sp = 0u;
    for (;;) {
        sum = 0u; cnt = 0u; mine = 0u;
#pragma unroll
        for (unsigned j = 0; j < 16; ++j) { const unsigned c = xb_ld(&bar[XB_XCNT(j)]); sum += c; cnt += (c > 0u) ? 1u : 0u; mine = (j == x) ? c : mine; }
        if (sum == G) break;
        __builtin_amdgcn_s_sleep(1);
        if ((++sp & 255u) == 0u) { if (xb_ld(&bar[XB_TMO])) break; if (sp > XB_SPIN_CAP) { atomicAdd(&bar[XB_TMO], 1u); break; } }
    }
    nloc = mine > 0u ? mine : 1u; nx = cnt > 0u ? cnt : 1u;
}

__device__ __forceinline__ void xcd_barrier(const XcdBarrier& b) {
    asm volatile("s_waitcnt vmcnt(0)" ::: "memory");
    __syncthreads();
    if (threadIdx.x == 0) {
        unsigned* bar = b.bar;
        __builtin_amdgcn_s_waitcnt(0);
        unsigned nloc = b.st[0], nx = b.st[1];
        if (nloc == 0u) { xcd_barrier_complete(bar, b.x, nloc, nx); b.st[0] = nloc; b.st[1] = nx; }
        const unsigned old = xb_add(&bar[XB_XSUB(b.x)], 1u);
        const unsigned gen = old / nloc;
        if (old + 1u == (gen + 1u) * nloc) {
            __builtin_amdgcn_fence(__ATOMIC_RELEASE, "agent");
            asm volatile("s_waitcnt vmcnt(0)" ::: "memory");
            const unsigned og = xb_add(&bar[XB_TOP], 1u);
            const unsigned tg = og / nx;
            if (og + 1u == (tg + 1u) * nx) xb_add(&bar[XB_TOPGEN], 1u);
            else XB_SPIN(xb_ld(&bar[XB_TOPGEN]) == tg, bar);
            __builtin_amdgcn_fence(__ATOMIC_ACQUIRE, "agent");
            xb_add(&bar[XB_XGEN(b.x)], 1u);
            asm volatile("s_waitcnt vmcnt(0)" ::: "memory");
        } else {
            XB_SPIN(xb_ld(&bar[XB_XGEN(b.x)]) == gen, bar);
            __builtin_amdgcn_fence(__ATOMIC_ACQUIRE, "agent");
            asm volatile("s_waitcnt vmcnt(0)" ::: "memory");
        }
    }
    __syncthreads();
}
#ifdef USE_CG
static __device__ __forceinline__ void grid_barrier(cg::grid_group& grid) {
    asm volatile("s_waitcnt vmcnt(0) lgkmcnt(0)" ::: "memory");
    __syncthreads();
    if (threadIdx.x == 0) { __builtin_amdgcn_fence(__ATOMIC_RELEASE, "agent"); asm volatile("s_waitcnt vmcnt(0)" ::: "memory"); }
    grid.sync();
    if (threadIdx.x == 0) { __builtin_amdgcn_fence(__ATOMIC_ACQUIRE, "agent"); asm volatile("s_waitcnt vmcnt(0)" ::: "memory"); }
    __syncthreads();
}
#define GRID_BARRIER() grid_barrier(grid)
#else
#define GRID_BARRIER() xcd_barrier(xbar)
#endif

#ifdef DUMP_AFTER
static __device__ __forceinline__ void dbg_dump(Frame& F, int mode) {
    const size_t gt = (size_t)F.vcu * NTHREADS + F.tid, NGT = (size_t)F.G * NTHREADS;
    const bf16_t* PROJ = (const bf16_t*)(F.ws + WS_PROJ); const bf16_t* WBUF = (const bf16_t*)(F.ws + WS_WBUF); const bf16_t* ABUF = (const bf16_t*)(F.ws + WS_ABUF);
    const bf16_t* POOLED = (const bf16_t*)(F.ws + WS_POOLED); const float* GC = (const float*)(F.ws + WS_GC); const bf16_t* Q2 = (const bf16_t*)(F.ws + WS_Q2);
    const int* IDX = (const int*)(F.ws + WS_IDX); const float* GATEW = (const float*)(F.ws + WS_GATEW);
    for (size_t i = gt; i < (size_t)NTOK * DM; i += NGT) {
        const size_t t = i >> 10; const int cidx = (int)(i & 1023);
        float v = 0.f;
        if (mode == 1 || mode == 3) { const bf16_t* r = PROJ + t * P1N; v = bf2f(r[cidx]) + bf2f(r[1024 + cidx]) + bf2f(r[2048 + cidx]) + bf2f(r[3072 + cidx]) + bf2f(r[3584 + cidx]); }
        if (mode == 2) v = bf2f(POOLED[t * 512 + (cidx & 511)]);
        if (mode == 3) v += bf2f(WBUF[t * DM + cidx]) + bf2f(ABUF[(t >> 6) * 8 * 4096 + (size_t)(cidx >> 7) * 4096 + (t & 63) * 64 + (cidx & 63)]) + GC[t * 8 + (cidx & 7)];
        if (mode == 4 || mode == 5) v = bf2f(PROJ[t * P1N + C_V + cidx]);
        if (mode == 6 || mode == 7) v = bf2f(ABUF[t * DM + cidx]);
        if (mode == 9) v = bf2f(Q2[t * 2048 + cidx]) + bf2f(Q2[t * 2048 + 1024 + cidx]);
        if (mode == 10) v = (float)IDX[t * 128 + (cidx & 127)] * 1e-3f + GATEW[t * 128 + (cidx & 127)];
        F.out[i] = v;
    }
}
#define DUMP(k) do { if (DUMP_AFTER == (k)) { if ((k) != 8) dbg_dump(F, (k)); return; } } while (0)
#else
#define DUMP(k) do {} while (0)
#endif

#ifdef TIMING_A
#define TS_OFF (LDS_BYTES - 256)
#define STAMP(k) do { if (blockIdx.x == 0 && threadIdx.x == 0) ((volatile LAS unsigned long long*)(F.lds + TS_OFF))[(k)] = __builtin_amdgcn_s_memrealtime(); } while (0)
#else
#define STAMP(k) do {} while (0)
#endif
#ifndef PHM
#define PHM 0x1fff
#endif
__global__ void __launch_bounds__(NTHREADS, 2) hybrid_fwd(Params p) {
    extern __shared__ __attribute__((aligned(16))) unsigned char lds_raw[];
#ifdef USE_CG
    cg::grid_group grid = cg::this_grid();
#endif
    Frame F;
    F.lds = (LAS unsigned char*)lds_raw;
    F.tid = threadIdx.x; F.lane = F.tid & 63; F.wave = __builtin_amdgcn_readfirstlane(F.tid >> 6);
    F.G = gridDim.x; { const int bx = blockIdx.x; F.vcu = (F.G % 8 == 0) ? (bx % 8) * (F.G / 8) + bx / 8 : bx; }
    F.x = p.in[0]; F.mix_norm_w = p.in[1]; F.w_in = p.in[2]; F.pool_w = p.in[3]; F.pool_scale = p.in[4]; F.conv_w = p.in[5]; F.a_log = p.in[6]; F.dt_bias = p.in[7]; F.dn_norm_w = p.in[8];
    F.w_pool_up = p.in[9]; F.w_dn_up = p.in[10]; F.w_mix_out = p.in[11]; F.ffn_norm_w = p.in[12]; F.w_query = p.in[13]; F.keys1 = p.in[14]; F.keys2 = p.in[15]; F.peer_down = p.in[16]; F.peer_up = p.in[17]; F.final_norm_w = p.in[18];
    F.out = p.out; F.ws = p.ws;
    unsigned char* ws = p.ws;
#ifndef USE_CG
    {
        volatile LAS unsigned* st = (volatile LAS unsigned*)(F.lds + XB_ST_OFF);
        if (threadIdx.x < 2) st[threadIdx.x] = 0u;
        __syncthreads();
    }
    const XcdBarrier xbar = xcd_barrier_post((unsigned*)ws, (volatile LAS unsigned*)(F.lds + XB_ST_OFF));
#endif
#ifndef USE_CG
    int xticket = 0;
    if (threadIdx.x == 0) xticket = (int)xb_add((unsigned*)ws + 3584 + 64 * xbar.x, 1u);
#endif
    bf16_t* XN = (bf16_t*)p.out; bf16_t* GB = (bf16_t*)((unsigned char*)p.out + 128 * MiB);
    bf16_t* PROJ = (bf16_t*)(ws + WS_PROJ); bf16_t* WIN = (bf16_t*)(ws + WS_WIN);
    bf16_t* GA = (bf16_t*)(ws + WS_WBUF); bf16_t* MERGED = (bf16_t*)(ws + WS_ABUF); bf16_t* HBp = (bf16_t*)(ws + WS_WBUF);

#ifdef TIMING_A
    if (blockIdx.x == 0 && threadIdx.x < 4) ((volatile LAS unsigned long long*)(F.lds + LDS_BYTES - 256 + 128))[threadIdx.x] = 0ull;
#endif
    STAMP(0);
#ifdef ZERO_FILL
    {
        const size_t gt = (size_t)F.vcu * NTHREADS + F.tid, NGT = (size_t)F.G * NTHREADS;
        u32x4 z = {0u, 0u, 0u, 0u};
        u32x4* w4 = (u32x4*)ws; for (size_t i = gt; i < WS_END / 16; i += NGT) w4[i] = z;
        u32x4* o4 = (u32x4*)p.out; for (size_t i = gt; i < (size_t)NTOK * DM * 4 / 16; i += NGT) o4[i] = z;
    }
    GRID_BARRIER();
#endif
#if (PHM >> 0) & 1
    p0_prologue(F);
#endif
#ifdef P2_CHECK
    if (blockIdx.x == 0 && threadIdx.x == 0) *(unsigned*)(ws + 64) = 0u;
#endif
    GRID_BARRIER();
    STAMP(1);
#if (PHM >> 1) & 1
    {
        pg8::Gemm g{XN, WIN, NTOK, P1N, DM, DM, DM}; pg8::StaticOrder S; S.init(NTOK, P1N, F.G, (int)blockIdx.x);
        pg8::EpiStore<0> E{PROJ, nullptr, P1N, 0, (bf16_t*)(ws + WS_HALO), 1.0f};
        pg8::gemm_phase<pg8::EpiStore<0>, pg8::StaticOrder, true, true>(F.lds, g, S, E);
    }
#endif
    GRID_BARRIER();
    DUMP(1);
    STAMP(2);
#if (PHM >> 2) & 1
    p2h_pool(F);
    __syncthreads();
#endif
    DUMP(2);
    STAMP(3);
#if (PHM >> 3) & 1
    p2_chunk_prep(F, P2Out{(bf16_t*)(ws + WS_PROJ) + C_Q, (bf16_t*)(ws + WS_PROJ) + C_K, (bf16_t*)(ws + WS_PROJ) + C_V, P1N, (bf16_t*)(ws + WS_WBUF), (bf16_t*)(ws + WS_ABUF), (float*)(ws + WS_GC), 0, 0, NBATCH * NCHUNK * 8});
#endif
    GRID_BARRIER();
    DUMP(3);
    STAMP(4);
#if (PHM >> 4) & 1
    p3_scan(F);
#endif
    GRID_BARRIER();
    DUMP(4);
    STAMP(5);
#if (PHM >> 5) & 1
    p4_gated_norm(F);
#endif
#if (PHM >> 6) & 1
    {
        pg8::Gemm g{(const bf16_t*)(ws + WS_ABUF + 64 * MiB), WIN + (size_t)P1N * DM, NTOK, 2048, DM / 2, DM / 2, DM / 2}; pg8::StaticOrder S; S.init(NTOK, 2048, F.G, (int)blockIdx.x);
        pg8::EpiStore<1> E{GA, GB, DM, 1024, nullptr, 1.0f / (XN8_SCALE * WG8_SCALE)};
        pg8::gemm_phase<pg8::EpiStore<1>, pg8::StaticOrder, true, true, true>(F.lds, g, S, E);
    }
#endif
    GRID_BARRIER();
    DUMP(5);
    STAMP(6);
#if (PHM >> 7) & 1
    {
        pg8::Gemm g{(const bf16_t*)(ws + WS_POOLED), (const bf16_t*)(ws + WS_WPU), NTOK, DM, 512, 512, 512}; pg8::StaticOrder S; S.init(NTOK, DM, F.G, (int)blockIdx.x);
        pg8::EpiGateMul<false> E{MERGED, GA, DM, 1.0f};
        pg8::gemm_phase<pg8::EpiGateMul<false>, pg8::StaticOrder, true, true>(F.lds, g, S, E);
    }
#endif
    STAMP(7);
#if (PHM >> 8) & 1
    {
        pg8::Gemm g{(const bf16_t*)p.out, (const bf16_t*)(ws + WS_WDU), NTOK, DM, DM / 2, DM / 2, DM / 2}; pg8::StaticOrder S; S.init(NTOK, DM, F.G, (int)blockIdx.x);
        pg8::EpiGateMul<true> E{MERGED, GB, DM, 1.0f / (ON8_SCALE * WG8_SCALE)};
        pg8::gemm_phase<pg8::EpiGateMul<true>, pg8::StaticOrder, true, true, true>(F.lds, g, S, E);
    }
#endif
    GRID_BARRIER();
    DUMP(7);
    STAMP(8);
#if (PHM >> 9) & 1
    {
        pg8::Gemm g{MERGED, (const bf16_t*)(ws + WS_WMX), NTOK, DM, DM, DM, DM}; pg8::StaticOrder S; S.init(NTOK, DM, F.G, (int)blockIdx.x);
        pg8::EpiResid E{F.x, p.out, HBp, (float*)(ws + WS_SSQ), DM};
        pg8::gemm_phase<pg8::EpiResid, pg8::StaticOrder, true, true>(F.lds, g, S, E);
    }
#endif
    GRID_BARRIER();
    DUMP(8);
    STAMP(9);
#if (PHM >> 10) & 1
    {
        pg8::Gemm g{HBp, (const bf16_t*)(ws + WS_WQ), NTOK, 2048, DM, DM, DM}; pg8::StaticOrder S; S.init(NTOK, 2048, F.G, (int)blockIdx.x);
        pg8::EpiRowScale E{(bf16_t*)(ws + WS_Q2), (const float*)(ws + WS_SSQ), 2048, 1.0f / DM, EPS};
        pg8::gemm_phase<pg8::EpiRowScale, pg8::StaticOrder, true, true>(F.lds, g, S, E);
    }
#endif
    GRID_BARRIER();
    DUMP(9);
    STAMP(10);
#if (PHM >> 11) & 1
    p10_topk(F);
#endif
    GRID_BARRIER();
    DUMP(10);
    STAMP(11);
#if (PHM >> 12) & 1
    {
        F.sl_n = F.G / 8; F.sl_s = F.vcu / F.sl_n; F.sl_rk = F.vcu % F.sl_n;
#ifndef USE_CG
        bool even = true;
#pragma unroll
        for (int j = 0; j < 16; ++j) { const unsigned cnt = xb_ld((unsigned*)ws + XB_XCNT(j)); even = even && (cnt == ((j < 8) ? (unsigned)F.sl_n : 0u)); }
        const int tk = __builtin_amdgcn_readfirstlane(__shfl(xticket, 0));
        volatile LAS int* tkl = (volatile LAS int*)(F.lds + XB_ST_OFF + 64);
        if (threadIdx.x == 0) tkl[0] = tk;
        __syncthreads();
        const int tkb = tkl[0];
        if (even && (F.G % 8 == 0) && xbar.x < 8u && tkb < F.sl_n) { F.sl_s = (int)xbar.x; F.sl_rk = tkb; }
#endif
    }
#ifdef ABLATE_P11A
    { TACC_T0(); p11a_down<1>(F); GRID_BARRIER(); TACC_ADD(1); }
    { TACC_T0(); p11a_down<2>(F); GRID_BARRIER(); TACC_ADD(2); }
#endif
    { TACC_T0(); p11a_down<0>(F); GRID_BARRIER(); TACC_ADD(0); }
    { p11b_coef(F); GRID_BARRIER(); }
    { TACC_T0(); p11c_up(F); GRID_BARRIER(); TACC_ADD(3); }
    { p11d_final(F); }
#endif
#ifdef P2_CHECK
    GRID_BARRIER();
    if (blockIdx.x == 0 && threadIdx.x == 0) p.out[0] += 2.0f + 100000.0f * __uint_as_float(*(volatile unsigned*)(ws + 64));
#endif
#ifdef TIMING_A
    GRID_BARRIER();
    STAMP(12);
    if (blockIdx.x == 0) {
        asm volatile("s_waitcnt lgkmcnt(0)" ::: "memory"); __syncthreads();
        volatile LAS unsigned long long* ts = (volatile LAS unsigned long long*)(F.lds + TS_OFF);
        const float tot = (float)(ts[12] - ts[0]);
        volatile LAS unsigned long long* ta = (volatile LAS unsigned long long*)(F.lds + TS_OFF + 128);
        const float fa = (TIMING_A >= 100) ? (float)ta[TIMING_A - 100] / tot : (float)(ts[(TIMING_A % 100) + 1] - ts[TIMING_A % 100]) / tot;
        const float fb = (TIMING_B >= 100) ? (float)ta[TIMING_B - 100] / tot : (float)(ts[(TIMING_B % 100) + 1] - ts[TIMING_B % 100]) / tot;
        if (threadIdx.x == 0) p.out[0] += 2.0f + 100.0f * fa;
        const float db = sqrtf(fb);
        for (int k = 0; k < 128; ++k) p.out[1024 + threadIdx.x + 512 * k] += db;
    }
#endif
}

extern "C" void kernel_launch(void* const* d_in, const int* in_sizes, int n_in, void* d_out, int out_size, void* d_ws, size_t ws_size, hipStream_t stream) {
    static int grid = 0;
    if (grid == 0) {
        if (n_in != 19 || in_sizes[0] != NTOK * DM || out_size != NTOK * DM || ws_size < WS_END) {
            fprintf(stderr, "kernel_launch: unexpected shapes: n_in %d in0 %d out %d ws %zu (need %zu); nothing launched\n", n_in, n_in > 0 ? in_sizes[0] : -1, out_size, ws_size, (size_t)WS_END); grid = -1; return; }
        int dev = 0, cus = 0, per_cu = 0;
        (void)hipGetDevice(&dev); (void)hipDeviceGetAttribute(&cus, hipDeviceAttributeMultiprocessorCount, dev);
        (void)hipFuncSetAttribute((const void*)hybrid_fwd, hipFuncAttributeMaxDynamicSharedMemorySize, LDS_BYTES);
        (void)hipOccupancyMaxActiveBlocksPerMultiprocessor(&per_cu, (const void*)hybrid_fwd, NTHREADS, LDS_BYTES);
        if (per_cu < 1) { fprintf(stderr, "kernel_launch: occupancy query says %d blocks per CU\n", per_cu); per_cu = 1; }
        grid = cus;
    }
    if (grid < 0) return;
    Params p{};
    for (int i = 0; i < 19; ++i) p.in[i] = (const float*)d_in[i];
    p.out = (float*)d_out; p.ws = (unsigned char*)d_ws;
#ifdef USE_CG
    void* args[] = {&p};
    hipError_t e = hipLaunchCooperativeKernel((const void*)hybrid_fwd, dim3(grid), dim3(NTHREADS), args, LDS_BYTES, stream);
    if (e != hipSuccess) fprintf(stderr, "cooperative launch failed: %s (grid %d)\n", hipGetErrorString(e), grid);
#else
    if (hipMemsetAsync(d_ws, 0, 32768, stream) != hipSuccess) { fprintf(stderr, "kernel_launch: hipMemsetAsync failed\n"); return; }
    hipLaunchKernelGGL(hybrid_fwd, dim3(grid), dim3(NTHREADS), LDS_BYTES, stream, p);
    const hipError_t e = hipPeekAtLastError();
    if (e != hipSuccess) fprintf(stderr, "launch failed: %s (grid %d)\n", hipGetErrorName(e), grid);
#endif
}
```

```cpp
#include <hip/hip_runtime.h>
#include <hip/hip_cooperative_groups.h>
#include <cstdio>
#include <cstdint>
namespace cg = cooperative_groups;
namespace pg8 {
#define PG8_LAS __attribute__((address_space(3)))
typedef unsigned short bf16_t;
typedef short bf16x8 __attribute__((ext_vector_type(8)));
typedef float f32x4 __attribute__((ext_vector_type(4)));
typedef unsigned u32x4 __attribute__((ext_vector_type(4)));
typedef int v4i_t __attribute__((ext_vector_type(4)));
typedef int v8i_t __attribute__((ext_vector_type(8)));
constexpr int BM = 256, BK = 64, HALF = 128, HTB = HALF * BK * 2  , STAGE_BYTES = 8 * HTB, NXCD = 8, WGM = 8;

__host__ __device__ __forceinline__ int lds_byte(int r, int c) { const int st = (r >> 4) * 2 + (c >> 5), rr = r & 15, cc = c & 31, ob = rr * 64 + cc * 2; return st * 1024 + (ob ^ (((ob >> 9) & 1) << 5)); }
__host__ __device__ __forceinline__ void stage_rc(int b, int& R, int& C) { const int st = b / 1024, sb = b % 1024, swz = sb ^ (((sb >> 9) & 1) << 5); R = (st >> 1) * 16 + swz / 64; C = (st & 1) * 32 + (swz % 64) / 2; }
__host__ __device__ __forceinline__ int perm32(int rho) { const int n = rho >> 4, i = rho & 15; return 8 * (i >> 2) + 4 * n + (i & 3); }

struct Unit { int pm, pn; };
struct Gemm { const bf16_t* A; const bf16_t* Bt; int M, N, K, lda, ldb; };

struct StaticOrder {
    int nM, nN, nwg, G, c;
    __host__ __device__ void init(int M, int N, int G_, int c_) { nM = M / BM; nN = N / BM; nwg = nM * nN; G = G_; c = c_; }
    __host__ __device__ bool next(int i, Unit& u) const {
        const long L = (long)i * G + c; if (L >= nwg) return false;
        int wgid = (int)L; { const int q = nwg / NXCD, r = nwg % NXCD, xcd = wgid % NXCD, off = wgid / NXCD; wgid = (xcd < r ? xcd * (q + 1) : r * (q + 1) + (xcd - r) * q) + off; }
        const int nig = WGM * nN, gid = wgid / nig, fm = gid * WGM, gsz = (nM - fm) < WGM ? (nM - fm) : WGM;
        u.pm = fm + ((wgid % nig) % gsz); u.pn = (wgid % nig) / gsz; return true;
    }
    __device__ __forceinline__ void a_ready(const Unit&) const {}
    __device__ __forceinline__ void done(const Unit&) const {}
};

typedef float f32x2_t __attribute__((ext_vector_type(2))); typedef __bf16 bf16x2_t __attribute__((ext_vector_type(2)));
__device__ __forceinline__ unsigned cvt_pk_bf16(float lo, float hi) { const f32x2_t v = {lo, hi}; const bf16x2_t b = __builtin_convertvector(v, bf16x2_t); return __builtin_bit_cast(unsigned, b); }
__device__ __forceinline__ float bf_lo(unsigned w) { return __uint_as_float(w << 16); }
__device__ __forceinline__ float bf_hi(unsigned w) { return __uint_as_float(w & 0xffff0000u); }
__device__ __forceinline__ float sigmoidf_(float x) { return __builtin_amdgcn_rcpf(1.0f + __expf(-x)); }

template <int ACT> struct EpiStore {
    static constexpr bool PERM = true, AFTER_DRAIN = false;
    bf16_t* O; bf16_t* O2; int ldc; int split_cols; bf16_t* halo; float pre;
    __device__ __forceinline__ void operator()(const f32x4 (&acc)[2][2][4][2], const Unit& u, int wr, int wc, int fr, int fq) const {
        const int row0 = u.pm * BM + wr * 64 + fr; int colt = u.pn * BM; bf16_t* base = O;
        if (split_cols && colt >= split_cols) { base = O2; colt -= split_cols; }
        const int col0 = colt + wc * 32 + 8 * fq;
#pragma unroll
        for (int ai = 0; ai < 2; ++ai)
#pragma unroll
            for (int m = 0; m < 4; ++m) { bf16_t* rowp = base + (size_t)(row0 + ai * HALF + m * 16) * ldc + col0;
#pragma unroll
                for (int bj = 0; bj < 2; ++bj) { f32x4 v0 = acc[ai][bj][m][0], v1 = acc[ai][bj][m][1];
                    if (ACT == 1) {
#pragma unroll
                        for (int e = 0; e < 4; ++e) { v0[e] = sigmoidf_(v0[e] * pre); v1[e] = sigmoidf_(v1[e] * pre); } }
                    u32x4 w; w.x = cvt_pk_bf16(v0[0], v0[1]); w.y = cvt_pk_bf16(v0[2], v0[3]); w.z = cvt_pk_bf16(v1[0], v1[1]); w.w = cvt_pk_bf16(v1[2], v1[3]);
                    *(u32x4*)(rowp + bj * HALF) = w;
                    if (ACT == 0 && m == 3) {
                        if (halo && fr >= 13 && u.pn >= 2 && u.pn < 14) { const int row = row0 + ai * HALF + m * 16; const int cn = (row >> 6) + 1;
                            if ((cn & 127) != 0) *(u32x4*)(halo + ((size_t)cn * 3 + (fr - 13)) * 3072 + (col0 + bj * HALF - 512)) = w; } } } }
    }
};
template <bool ADD> struct EpiGateMul {
    static constexpr bool PERM = true, AFTER_DRAIN = false;
    bf16_t* MG; const bf16_t* G; int ld; float pre;
    __device__ __forceinline__ void operator()(const f32x4 (&acc)[2][2][4][2], const Unit& u, int wr, int wc, int fr, int fq) const {
        const int row0 = u.pm * BM + wr * 64 + fr; const int col0 = u.pn * BM + wc * 32 + 8 * fq;
#pragma unroll
        for (int ai = 0; ai < 2; ++ai)
#pragma unroll
            for (int m = 0; m < 4; ++m) { const size_t off = (size_t)(row0 + ai * HALF + m * 16) * ld + col0;
#pragma unroll
                for (int bj = 0; bj < 2; ++bj) { const f32x4 v0 = acc[ai][bj][m][0] * pre, v1 = acc[ai][bj][m][1] * pre;
                    const u32x4 g = *(const u32x4*)(G + off + bj * HALF);
                    float o[8];
                    o[0] = bf_lo(g.x) * v0[0]; o[1] = bf_hi(g.x) * v0[1]; o[2] = bf_lo(g.y) * v0[2]; o[3] = bf_hi(g.y) * v0[3];
                    o[4] = bf_lo(g.z) * v1[0]; o[5] = bf_hi(g.z) * v1[1]; o[6] = bf_lo(g.w) * v1[2]; o[7] = bf_hi(g.w) * v1[3];
                    if (ADD) { const u32x4 p = *(const u32x4*)(MG + off + bj * HALF);
                        o[0] += bf_lo(p.x); o[1] += bf_hi(p.x); o[2] += bf_lo(p.y); o[3] += bf_hi(p.y); o[4] += bf_lo(p.z); o[5] += bf_hi(p.z); o[6] += bf_lo(p.w); o[7] += bf_hi(p.w); }
                    u32x4 w; w.x = cvt_pk_bf16(o[0], o[1]); w.y = cvt_pk_bf16(o[2], o[3]); w.z = cvt_pk_bf16(o[4], o[5]); w.w = cvt_pk_bf16(o[6], o[7]);
                    *(u32x4*)(MG + off + bj * HALF) = w; }
                asm volatile("" ::: "memory"); }
    }
};
struct EpiResid {
    static constexpr bool PERM = true, AFTER_DRAIN = false;
    const float* X; float* H; bf16_t* HB; float* SSQ; int ld;
    __device__ __forceinline__ void operator()(const f32x4 (&acc)[2][2][4][2], const Unit& u, int wr, int wc, int fr, int fq) const {
        const int row0 = u.pm * BM + wr * 64 + fr; const int col0 = u.pn * BM + wc * 32 + 8 * fq;
#pragma unroll
        for (int ai = 0; ai < 2; ++ai)
#pragma unroll
            for (int m = 0; m < 4; ++m) { const int row = row0 + ai * HALF + m * 16; const size_t off = (size_t)row * ld + col0; float ss = 0.f;
#pragma unroll
                for (int bj = 0; bj < 2; ++bj) {
                    const f32x4 x0 = *(const f32x4*)(X + off + bj * HALF), x1 = *(const f32x4*)(X + off + bj * HALF + 4);
                    const f32x4 h0 = x0 + acc[ai][bj][m][0], h1 = x1 + acc[ai][bj][m][1];
                    u32x4 w; w.x = cvt_pk_bf16(h0[0], h0[1]); w.y = cvt_pk_bf16(h0[2], h0[3]); w.z = cvt_pk_bf16(h1[0], h1[1]); w.w = cvt_pk_bf16(h1[2], h1[3]);
                    *(u32x4*)(HB + off + bj * HALF) = w;
                    ss += (h0[0] * h0[0] + h0[1] * h0[1]) + (h0[2] * h0[2] + h0[3] * h0[3]) + (h1[0] * h1[0] + h1[1] * h1[1]) + (h1[2] * h1[2] + h1[3] * h1[3]); }
                { typedef unsigned u32x2q __attribute__((ext_vector_type(2))); u32x2q r_ = __builtin_amdgcn_permlane16_swap(__float_as_uint(ss), __float_as_uint(ss), false, false); ss = __uint_as_float(r_[0]) + __uint_as_float(r_[1]);
                  r_ = __builtin_amdgcn_permlane32_swap(__float_as_uint(ss), __float_as_uint(ss), false, false); ss = __uint_as_float(r_[0]) + __uint_as_float(r_[1]); }
                if (fq == 0) SSQ[(size_t)row * 16 + u.pn * 4 + wc] = ss;
                asm volatile("" ::: "memory"); }
    }
};
struct EpiRowScale {
    static constexpr bool PERM = true, AFTER_DRAIN = false;
    bf16_t* O; const float* SSQ; int ldc; float inv_n, eps;
    __device__ __forceinline__ void operator()(const f32x4 (&acc)[2][2][4][2], const Unit& u, int wr, int wc, int fr, int fq) const {
        const int row0 = u.pm * BM + wr * 64 + fr; const int col0 = u.pn * BM + wc * 32 + 8 * fq;
        const int ln = fq * 16 + fr;
        float rsc[2];
#pragma unroll
        for (int ai = 0; ai < 2; ++ai) { const f32x4* sp = (const f32x4*)(SSQ + (size_t)(u.pm * BM + ai * HALF + wr * 64 + ln) * 16); const f32x4 s4 = (sp[0] + sp[1]) + (sp[2] + sp[3]);
            rsc[ai] = __builtin_amdgcn_rsqf(((s4[0] + s4[1]) + (s4[2] + s4[3])) * inv_n + eps); }
#pragma unroll
        for (int ai = 0; ai < 2; ++ai)
#pragma unroll
            for (int m = 0; m < 4; ++m) { const int row = row0 + ai * HALF + m * 16; const float sc = __shfl(rsc[ai], m * 16 + fr);
                bf16_t* rowp = O + (size_t)row * ldc + col0;
#pragma unroll
                for (int bj = 0; bj < 2; ++bj) { const f32x4 v0 = acc[ai][bj][m][0] * sc, v1 = acc[ai][bj][m][1] * sc;
                    u32x4 w; w.x = cvt_pk_bf16(v0[0], v0[1]); w.y = cvt_pk_bf16(v0[2], v0[3]); w.z = cvt_pk_bf16(v1[0], v1[1]); w.w = cvt_pk_bf16(v1[2], v1[3]);
                    *(u32x4*)(rowp + bj * HALF) = w; } }
    }
};

template <class Epi, class Sched, bool ALIGN_EPI = false, bool SP2 = false, bool F8 = false>
__device__ __forceinline__ void gemm_phase(PG8_LAS unsigned char* lds, const Gemm g, const Sched& S, const Epi& E) {
    int tid_ = threadIdx.x; asm volatile("" : "+v"(tid_));
    const int tid = tid_, wid = __builtin_amdgcn_readfirstlane(tid >> 6), lane = tid & 63, wr = wid >> 2, wc = wid & 3, fr = lane & 15, fq = lane >> 4;
    const int K = g.K, nt = K / BK;
    unsigned voffA[2], voffB[2];
#pragma unroll
    for (int i = 0; i < 2; ++i) { int R, C; stage_rc(tid * 16 + i * 8192, R, C); const int Rb = Epi::PERM ? ((R & ~31) + perm32(R & 31)) : R;
        voffA[i] = (unsigned)(R * g.lda + C) * 2u; voffB[i] = (unsigned)(Rb * g.ldb + C) * 2u; }
    const size_t kstep = (size_t)(BK * 2);
    const size_t hstepA = (size_t)HALF * g.lda * 2, hstepB = (size_t)HALF * g.ldb * 2;
    const size_t tstepA = 2 * hstepA, tstepB = 2 * hstepB;
    const unsigned ldsw = (unsigned)wid * 1024u;
    const int aoff = lds_byte(wr * 64 + fr, fq * 8), boff = lds_byte(wc * 32 + fr, fq * 8);
#define PG8_SA(b, h) (((b) * 2 + (h)) * HTB)
#define PG8_SB(b, h) ((4 + (b) * 2 + (h)) * HTB)
#define PG8_STAGE(bufoff, gbase, voff) do { _Pragma("unroll") for (int _i = 0; _i < 2; ++_i) \
        __builtin_amdgcn_global_load_lds((const unsigned*)((const char*)(gbase) + (voff)[_i]), (PG8_LAS unsigned*)(lds + (bufoff) + ldsw + _i * 8192), 16, 0, 0); } while (0)
#define PG8_CAT8(x0, x1) __builtin_shufflevector(x0, x1, 0, 1, 2, 3, 4, 5, 6, 7)
#define PG8_LDA(dst, b, h) do { if constexpr (F8) { _Pragma("unroll") for (int m = 0; m < 4; ++m) dst##8[m] = PG8_CAT8(*(const PG8_LAS v4i_t*)(lds + PG8_SA(b, h) + aoff + m * 2048), *(const PG8_LAS v4i_t*)(lds + PG8_SA(b, h) + aoff + m * 2048 + 1024)); } \
        else { _Pragma("unroll") for (int m = 0; m < 4; ++m) _Pragma("unroll") for (int k = 0; k < 2; ++k) dst[m][k] = *(const PG8_LAS bf16x8*)(lds + PG8_SA(b, h) + aoff + m * 2048 + k * 1024); } } while (0)
#define PG8_LDB(dst, b, h) do { if constexpr (F8) { _Pragma("unroll") for (int n = 0; n < 2; ++n) dst##8[n] = PG8_CAT8(*(const PG8_LAS v4i_t*)(lds + PG8_SB(b, h) + boff + n * 2048), *(const PG8_LAS v4i_t*)(lds + PG8_SB(b, h) + boff + n * 2048 + 1024)); } \
        else { _Pragma("unroll") for (int n = 0; n < 2; ++n) _Pragma("unroll") for (int k = 0; k < 2; ++k) dst[n][k] = *(const PG8_LAS bf16x8*)(lds + PG8_SB(b, h) + boff + n * 2048 + k * 1024); } } while (0)
#define PG8_MMA(ai, bj, At, Bt) do { __builtin_amdgcn_s_setprio(1); \
        if constexpr (F8) { _Pragma("unroll") for (int m = 0; m < 4; ++m) _Pragma("unroll") for (int n = 0; n < 2; ++n) \
            { if (m == 0 && n == 0) asm volatile("s_nop 1\n\tv_mfma_f32_16x16x128_f8f6f4 %0, %1, %2, %0" : "+v"(acc[ai][bj][m][n]) : "v"(Bt##8[n]), "v"(At##8[m]));     \
              else asm volatile("v_mfma_f32_16x16x128_f8f6f4 %0, %1, %2, %0" : "+v"(acc[ai][bj][m][n]) : "v"(Bt##8[n]), "v"(At##8[m])); } } \
        else { _Pragma("unroll") for (int m = 0; m < 4; ++m) _Pragma("unroll") for (int n = 0; n < 2; ++n) _Pragma("unroll") for (int k = 0; k < 2; ++k) \
            acc[ai][bj][m][n] = __builtin_amdgcn_mfma_f32_16x16x32_bf16(Bt[n][k], At[m][k], acc[ai][bj][m][n], 0, 0, 0); } \
        __builtin_amdgcn_s_setprio(0); } while (0)
#define PG8_WAIT_V(n) asm volatile("s_waitcnt vmcnt(" #n ")" ::: "memory")
#define PG8_WAIT_L(n) asm volatile("s_waitcnt lgkmcnt(" #n ")" ::: "memory")
#define PG8_BAR __builtin_amdgcn_s_barrier()
#define PG8_SCHED __builtin_amdgcn_sched_barrier(0)
    Unit cur, nxt; int ui = 0;
    if (!S.next(0, cur)) return;
    f32x4 acc[2][2][4][2];
#pragma unroll
    for (int a = 0; a < 2; ++a)
#pragma unroll
        for (int b = 0; b < 2; ++b)
#pragma unroll
            for (int m = 0; m < 4; ++m)
#pragma unroll
                for (int n = 0; n < 2; ++n) acc[a][b][m][n] = (f32x4){0.f, 0.f, 0.f, 0.f};
    bf16x8 At[4][2], B0[2][2], B1[2][2];
    v8i_t At8[4], B08[2], B18[2];
    const char* cA = (const char*)g.A + (size_t)cur.pm * tstepA; const char* cB = (const char*)g.Bt + (size_t)cur.pn * tstepB;
    S.a_ready(cur);
    if constexpr (SP2) {
        PG8_STAGE(PG8_SB(0, 0), cB, voffB); PG8_STAGE(PG8_SB(0, 1), cB + hstepB, voffB); PG8_STAGE(PG8_SA(0, 0), cA, voffA); PG8_STAGE(PG8_SA(0, 1), cA + hstepA, voffA);
        if (wr == 1) PG8_BAR;
        PG8_WAIT_V(2); PG8_BAR;
        PG8_STAGE(PG8_SB(1, 0), cB + kstep, voffB); PG8_STAGE(PG8_SA(1, 0), cA + kstep, voffA); PG8_STAGE(PG8_SB(1, 1), cB + hstepB + kstep, voffB);
        PG8_WAIT_V(6); PG8_BAR;
    } else {
        PG8_STAGE(PG8_SB(0, 0), cB, voffB); PG8_STAGE(PG8_SA(0, 0), cA, voffA); PG8_STAGE(PG8_SB(0, 1), cB + hstepB, voffB); PG8_STAGE(PG8_SA(0, 1), cA + hstepA, voffA);
        if (wr == 1) PG8_BAR;
        PG8_WAIT_V(4); PG8_BAR;
        PG8_STAGE(PG8_SB(1, 0), cB + kstep, voffB); PG8_STAGE(PG8_SA(1, 0), cA + kstep, voffA); PG8_STAGE(PG8_SB(1, 1), cB + hstepB + kstep, voffB);
        PG8_WAIT_V(6); PG8_BAR;
    }
    for (;;) {
        const bool has_next = S.next(ui + 1, nxt);
        const char* nA = has_next ? (const char*)g.A + (size_t)nxt.pm * tstepA : cA; const char* nB = has_next ? (const char*)g.Bt + (size_t)nxt.pn * tstepB : cB;
#pragma unroll 1
        for (int t = 0; t < nt; t += 2) {
            const bool last = (t == nt - 2);
            const char* a1 = cA + (size_t)(t + 1) * kstep;
            const char* a2 = last ? nA : cA + (size_t)(t + 2) * kstep; const char* b2 = last ? nB : cB + (size_t)(t + 2) * kstep;
            const char* a3 = a2 + kstep; const char* b3 = b2 + kstep;
            if (last && has_next) S.a_ready(nxt);
            if constexpr (SP2) {
            PG8_LDB(B0, 0, 0); PG8_LDB(B1, 0, 1); PG8_SCHED; PG8_LDA(At, 0, 0); PG8_STAGE(PG8_SA(1, 1), a1 + hstepA, voffA);
            PG8_WAIT_V(8); PG8_WAIT_L(0); PG8_BAR; PG8_MMA(0, 0, At, B0); PG8_MMA(0, 1, At, B1); PG8_BAR; PG8_SCHED;
            PG8_LDA(At, 0, 1); PG8_STAGE(PG8_SB(0, 0), b2, voffB); PG8_STAGE(PG8_SB(0, 1), b2 + hstepB, voffB); PG8_STAGE(PG8_SA(0, 0), a2, voffA);
            PG8_WAIT_V(8); PG8_WAIT_L(0); PG8_BAR; PG8_MMA(1, 0, At, B0); PG8_MMA(1, 1, At, B1); PG8_BAR; PG8_SCHED;
            PG8_LDB(B0, 1, 0); PG8_LDB(B1, 1, 1); PG8_SCHED; PG8_LDA(At, 1, 0); PG8_STAGE(PG8_SA(0, 1), a2 + hstepA, voffA);
            PG8_WAIT_V(8); PG8_WAIT_L(0); PG8_BAR; PG8_MMA(0, 0, At, B0); PG8_MMA(0, 1, At, B1); PG8_BAR; PG8_SCHED;
            PG8_LDA(At, 1, 1); PG8_STAGE(PG8_SB(1, 0), b3, voffB); PG8_STAGE(PG8_SB(1, 1), b3 + hstepB, voffB); PG8_STAGE(PG8_SA(1, 0), a3, voffA);
            PG8_WAIT_V(8); PG8_WAIT_L(0); PG8_BAR; PG8_MMA(1, 0, At, B0); PG8_MMA(1, 1, At, B1); PG8_BAR; PG8_SCHED;
            } else {
            PG8_LDB(B0, 0, 0); PG8_SCHED; PG8_LDA(At, 0, 0); PG8_STAGE(PG8_SA(1, 1), a1 + hstepA, voffA);
            PG8_WAIT_L(8); PG8_BAR; PG8_WAIT_L(0); PG8_MMA(0, 0, At, B0); PG8_BAR; PG8_SCHED;
            PG8_LDB(B1, 0, 1); PG8_STAGE(PG8_SB(0, 0), b2, voffB);
            PG8_BAR; PG8_WAIT_L(0); PG8_MMA(0, 1, At, B1); PG8_BAR;
            PG8_LDA(At, 0, 1); PG8_STAGE(PG8_SA(0, 0), a2, voffA);
            PG8_BAR; PG8_WAIT_L(0); PG8_MMA(1, 0, At, B0); PG8_BAR; PG8_SCHED;
            PG8_STAGE(PG8_SB(0, 1), b2 + hstepB, voffB);
            PG8_WAIT_V(6); PG8_BAR; PG8_MMA(1, 1, At, B1); PG8_BAR;
            PG8_LDB(B0, 1, 0); PG8_SCHED; PG8_LDA(At, 1, 0); PG8_STAGE(PG8_SA(0, 1), a2 + hstepA, voffA);
            PG8_WAIT_L(8); PG8_BAR; PG8_WAIT_L(0); PG8_MMA(0, 0, At, B0); PG8_BAR; PG8_SCHED;
            PG8_LDB(B1, 1, 1); PG8_STAGE(PG8_SB(1, 0), b3, voffB);
            PG8_BAR; PG8_WAIT_L(0); PG8_MMA(0, 1, At, B1); PG8_BAR;
            PG8_LDA(At, 1, 1); PG8_STAGE(PG8_SA(1, 0), a3, voffA);
            PG8_BAR; PG8_WAIT_L(0); PG8_MMA(1, 0, At, B0); PG8_BAR; PG8_SCHED;
            PG8_STAGE(PG8_SB(1, 1), b3 + hstepB, voffB);
            PG8_WAIT_V(6); PG8_BAR; PG8_MMA(1, 1, At, B1); PG8_BAR;
            }
        }
        if constexpr (ALIGN_EPI) { if (wr == 0) PG8_BAR; }
        if constexpr (F8) {
            asm volatile("s_nop 15\n\ts_nop 15" : "+v"(acc[0][0][0][0]), "+v"(acc[0][0][0][1]), "+v"(acc[0][0][1][0]), "+v"(acc[0][0][1][1]), "+v"(acc[0][0][2][0]), "+v"(acc[0][0][2][1]), "+v"(acc[0][0][3][0]), "+v"(acc[0][0][3][1]));
            asm volatile("" : "+v"(acc[0][1][0][0]), "+v"(acc[0][1][0][1]), "+v"(acc[0][1][1][0]), "+v"(acc[0][1][1][1]), "+v"(acc[0][1][2][0]), "+v"(acc[0][1][2][1]), "+v"(acc[0][1][3][0]), "+v"(acc[0][1][3][1]));
            asm volatile("" : "+v"(acc[1][0][0][0]), "+v"(acc[1][0][0][1]), "+v"(acc[1][0][1][0]), "+v"(acc[1][0][1][1]), "+v"(acc[1][0][2][0]), "+v"(acc[1][0][2][1]), "+v"(acc[1][0][3][0]), "+v"(acc[1][0][3][1]));
            asm volatile("" : "+v"(acc[1][1][0][0]), "+v"(acc[1][1][0][1]), "+v"(acc[1][1][1][0]), "+v"(acc[1][1][1][1]), "+v"(acc[1][1][2][0]), "+v"(acc[1][1][2][1]), "+v"(acc[1][1][3][0]), "+v"(acc[1][1][3][1]));
        }
        if constexpr (!Epi::AFTER_DRAIN) { E(acc, cur, wr, wc, fr, fq); S.done(cur); }
        if (!has_next) break;
#pragma unroll
        for (int a = 0; a < 2; ++a)
#pragma unroll
            for (int b = 0; b < 2; ++b)
#pragma unroll
                for (int m = 0; m < 4; ++m)
#pragma unroll
                    for (int n = 0; n < 2; ++n) acc[a][b][m][n] = (f32x4){0.f, 0.f, 0.f, 0.f};
        cur = nxt; cA = nA; cB = nB; ++ui;
        if constexpr (ALIGN_EPI) { if (wr == 1) PG8_BAR; }
    }
    PG8_WAIT_V(0);
    if constexpr (!ALIGN_EPI) { if (wr == 0) PG8_BAR; }
    PG8_BAR;
    if constexpr (Epi::AFTER_DRAIN) { E.fused(acc, cur, wr, wc, fr, fq, lds, wid, lane); S.done(cur); }
#undef PG8_SA
#undef PG8_SB
#undef PG8_STAGE
#undef PG8_LDA
#undef PG8_LDB
#undef PG8_MMA
#undef PG8_CAT8
#undef PG8_WAIT_V
#undef PG8_WAIT_L
#undef PG8_BAR
#undef PG8_SCHED
}
}

constexpr int NTOK = 65536, SEQ = 8192, NBATCH = 8, DM = 1024, INC = 6672, P1N = 4608, NCHUNK = SEQ / 64;
constexpr float EPS = 1e-6f;
constexpr int NWAVES = 8, NTHREADS = 512;
constexpr int LDS_BYTES = 147456;
constexpr int XB_ST_OFF = LDS_BYTES - 512;
constexpr size_t MiB = (size_t)1 << 20;
constexpr size_t WS_SSQ = 1008 * MiB;
constexpr size_t WS_KEYS = 1 * MiB;
constexpr size_t WS_POOLW = 1 * MiB + 512 * 1024;
constexpr size_t WS_WPU = 2 * MiB, WS_WDU = 3 * MiB, WS_WMX = 5 * MiB, WS_WQ = 7 * MiB, WS_WIN = 11 * MiB;
constexpr size_t WS_EDOWN = 24 * MiB, WS_EUP = 56 * MiB;
constexpr float ED_SCALE = 32.0f, EU_SCALE = 4.0f;
constexpr size_t WS_BETA = 88 * MiB, WS_GRAW = 90 * MiB, WS_GC = 92 * MiB;
constexpr size_t WS_HALO = 94 * MiB;
constexpr size_t WS_POOLED = 112 * MiB;
constexpr size_t WS_WBUF = 176 * MiB;
constexpr size_t WS_ABUF = 304 * MiB;
constexpr size_t WS_PROJ = 432 * MiB;
constexpr size_t WS_Q2 = WS_PROJ, WS_IDX = WS_PROJ + 256 * MiB, WS_GATEW = WS_PROJ + 288 * MiB;
constexpr size_t WS_END = 1012 * MiB;
constexpr float ON8_SCALE = 4.0f;
constexpr float XN8_SCALE = 4.0f, WG8_SCALE = 64.0f;
constexpr int C_XA = 0, C_Q = 512, C_K = 1536, C_V = 2560, C_Z = 3584;

#define LAS __attribute__((address_space(3)))
typedef unsigned short bf16_t;
typedef short bf16x8 __attribute__((ext_vector_type(8)));
typedef float f32x4 __attribute__((ext_vector_type(4)));
typedef unsigned u32x4 __attribute__((ext_vector_type(4)));
typedef unsigned u32x2 __attribute__((ext_vector_type(2)));
#define LDS_WAIT() asm volatile("s_waitcnt lgkmcnt(0)" ::: "memory")
#define VM_WAIT() asm volatile("s_waitcnt vmcnt(0)" ::: "memory")

__device__ __forceinline__ unsigned pk2(float lo, float hi) { return pg8::cvt_pk_bf16(lo, hi); }
__device__ __forceinline__ unsigned short f2bf(float f) { return (unsigned short)(pg8::cvt_pk_bf16(f, 0.f) & 0xffffu); }
__device__ __forceinline__ float bflo(unsigned w) { return __uint_as_float(w << 16); }
__device__ __forceinline__ float bfhi(unsigned w) { return __uint_as_float(w & 0xffff0000u); }
__device__ __forceinline__ float bf2f(unsigned short b) { return __uint_as_float((unsigned)b << 16); }
__device__ __forceinline__ void unpack8(const u32x4 w, float* f) { f[0] = bflo(w.x); f[1] = bfhi(w.x); f[2] = bflo(w.y); f[3] = bfhi(w.y); f[4] = bflo(w.z); f[5] = bfhi(w.z); f[6] = bflo(w.w); f[7] = bfhi(w.w); }
__device__ __forceinline__ u32x4 pack8(const float* f) { u32x4 w; w.x = pk2(f[0], f[1]); w.y = pk2(f[2], f[3]); w.z = pk2(f[4], f[5]); w.w = pk2(f[6], f[7]); return w; }
__device__ __forceinline__ float wave_sum(float v) {
#pragma unroll
    for (int o = 1; o < 64; o <<= 1) v += __shfl_xor(v, o);
    return v;
}
template <int CTRL> __device__ __forceinline__ float dpp_f(float v) { return __int_as_float(__builtin_amdgcn_update_dpp(0, __float_as_int(v), CTRL, 0xF, 0xF, false)); }
typedef unsigned u32x2sw __attribute__((ext_vector_type(2)));
__device__ __forceinline__ float xlane1(float x) { return dpp_f<0xB1>(x); }
__device__ __forceinline__ float xlane2(float x) { return dpp_f<0x4E>(x); }
__device__ __forceinline__ float xlane4(float x) { return dpp_f<0x141>(dpp_f<0x1B>(x)); }
__device__ __forceinline__ float xlane8(float x) { return dpp_f<0x128>(x); }
__device__ __forceinline__ float xlane16(float x, bool odd_row) { const u32x2sw r = __builtin_amdgcn_permlane16_swap(__float_as_uint(x), __float_as_uint(x), false, false); return __uint_as_float(odd_row ? r[0] : r[1]); }
__device__ __forceinline__ float xlane32(float x, bool upper) { const u32x2sw r = __builtin_amdgcn_permlane32_swap(__float_as_uint(x), __float_as_uint(x), false, false); return __uint_as_float(upper ? r[0] : r[1]); }
__device__ __forceinline__ float xsum16(float s) { const u32x2sw r = __builtin_amdgcn_permlane16_swap(__float_as_uint(s), __float_as_uint(s), false, false); return __uint_as_float(r[0]) + __uint_as_float(r[1]); }
__device__ __forceinline__ float xsum32(float s) { const u32x2sw r = __builtin_amdgcn_permlane32_swap(__float_as_uint(s), __float_as_uint(s), false, false); return __uint_as_float(r[0]) + __uint_as_float(r[1]); }
__device__ __forceinline__ float wave_sum_dpp(float s) { s += dpp_f<0xB1>(s); s += dpp_f<0x4E>(s); s += dpp_f<0x141>(s); s += dpp_f<0x140>(s); return xsum32(xsum16(s)); }
__device__ __forceinline__ f32x4 mfma16(bf16x8 a, bf16x8 b, f32x4 c) { return __builtin_amdgcn_mfma_f32_16x16x32_bf16(a, b, c, 0, 0, 0); }
__device__ __forceinline__ bf16x8 ldfrag(const LAS bf16_t* p, int ld, int row0, int k0, int lane) { return *(const LAS bf16x8*)(p + (row0 + (lane & 15)) * ld + k0 + 8 * (lane >> 4)); }

struct Params { const float* in[19]; float* out; unsigned char* ws; };

struct Frame {
    LAS unsigned char* lds;
    int tid, lane, wave, vcu, G;
    int sl_s, sl_rk, sl_n;
    __device__ __forceinline__ void fresh() { int t = threadIdx.x; asm volatile("" : "+v"(t)); tid = t; lane = t & 63; wave = __builtin_amdgcn_readfirstlane(t >> 6); }
    const float *x, *mix_norm_w, *w_in, *pool_w, *pool_scale, *conv_w, *a_log, *dt_bias, *dn_norm_w, *w_pool_up, *w_dn_up, *w_mix_out, *ffn_norm_w, *w_query, *keys1, *keys2, *peer_down, *peer_up, *final_norm_w;
    float* out; unsigned char* ws;
};


#ifdef TIMING_A
#define TACC_T0() const unsigned long long tacc_t0_ = __builtin_amdgcn_s_memrealtime()
#define TACC_ADD(k) do { if (blockIdx.x == 0 && threadIdx.x == 0) ((volatile LAS unsigned long long*)(F.lds + LDS_BYTES - 256 + 128))[(k)] += __builtin_amdgcn_s_memrealtime() - tacc_t0_; } while (0)
#else
#define TACC_T0() do {} while (0)
#define TACC_ADD(k) do {} while (0)
#endif
__device__ __forceinline__ unsigned pack4_fp8(float a, float b, float c, float d, float s) {
    a = __builtin_amdgcn_fmed3f(a * s, -448.f, 448.f); b = __builtin_amdgcn_fmed3f(b * s, -448.f, 448.f); c = __builtin_amdgcn_fmed3f(c * s, -448.f, 448.f); d = __builtin_amdgcn_fmed3f(d * s, -448.f, 448.f);
    int v = __builtin_amdgcn_cvt_pk_fp8_f32(a, b, 0, false); v = __builtin_amdgcn_cvt_pk_fp8_f32(c, d, v, true); return (unsigned)v; }
__device__ __forceinline__ void p0_transpose_item(const float* W, int ldw, int c0, const float* kscale, int K, bf16_t* WT, int nblk, LAS float* scr, int item, int lane, float f8s = 0.f) {
    const int kb = item / nblk, nb = item % nblk, k0 = 64 * kb, n0 = 32 * nb;
#pragma unroll 8
    for (int i = 0; i < 32; ++i) { const int kk = 2 * i + (lane >> 5); float v = W[(size_t)(k0 + kk) * ldw + c0 + n0 + (lane & 31)]; if (kscale) v *= kscale[k0 + kk]; scr[kk * 33 + (lane & 31)] = v; }
    LDS_WAIT();
    const int c = lane & 7;
#pragma unroll
    for (int j = 0; j < 4; ++j) { const int n = (lane >> 3) + 8 * j; const LAS float* s = scr + (8 * c) * 33 + n;
        if (f8s != 0.f) { const unsigned v0 = pack4_fp8(s[0 * 33], s[1 * 33], s[2 * 33], s[3 * 33], f8s), v1 = pack4_fp8(s[4 * 33], s[5 * 33], s[6 * 33], s[7 * 33], f8s);
            u32x2 o8; o8.x = v0; o8.y = v1; *(u32x2*)((unsigned char*)WT + (size_t)(n0 + n) * K + k0 + 8 * c) = o8; }
        else { u32x4 o; o.x = pk2(s[0 * 33], s[1 * 33]); o.y = pk2(s[2 * 33], s[3 * 33]); o.z = pk2(s[4 * 33], s[5 * 33]); o.w = pk2(s[6 * 33], s[7 * 33]);
            *(u32x4*)(WT + (size_t)(n0 + n) * K + k0 + 8 * c) = o; } }
    LDS_WAIT();
}
__device__ __forceinline__ float softplusf_(float x) { return x > 15.f ? x : log1pf(expf(x)); }

__device__ __forceinline__ void p0_prologue(Frame& F) {
    F.fresh();
    const int gw = F.vcu * NWAVES + F.wave, NGW = F.G * NWAVES;
    const int gt = F.vcu * NTHREADS + F.tid, NGT = F.G * NTHREADS;
    unsigned char* ws = F.ws;
    {
        LAS float* scr = (LAS float*)(F.lds + F.wave * 8448);
        constexpr int I_IN1 = 16 * (P1N / 32), I_IN2 = 16 * (2048 / 32), I_DU = 16 * 32, I_MX = 16 * 32, I_WQ = 16 * 64;
        constexpr int NITEMS = I_IN1 + I_IN2 + I_DU + I_MX + I_WQ;
        bf16_t* WIN = (bf16_t*)(ws + WS_WIN);
#pragma unroll 1
        for (int it = gw; it < NITEMS; it += NGW) {
            int r = it;
            if (r < I_IN1) { p0_transpose_item(F.w_in, INC, 0, nullptr, DM, WIN, P1N / 32, scr, r, F.lane); continue; } r -= I_IN1;
            if (r < I_IN2) { p0_transpose_item(F.w_in, INC, 4624, nullptr, DM, WIN + (size_t)P1N * DM, 2048 / 32, scr, r, F.lane, WG8_SCALE); continue; } r -= I_IN2;
            if (r < I_DU) { p0_transpose_item(F.w_dn_up, DM, 0, nullptr, DM, (bf16_t*)(ws + WS_WDU), 32, scr, r, F.lane, WG8_SCALE); continue; } r -= I_DU;
            if (r < I_MX) { p0_transpose_item(F.w_mix_out, DM, 0, nullptr, DM, (bf16_t*)(ws + WS_WMX), 32, scr, r, F.lane); continue; } r -= I_MX;
            { p0_transpose_item(F.w_query, 2048, 0, F.ffn_norm_w, DM, (bf16_t*)(ws + WS_WQ), 64, scr, r, F.lane); }
        }
    }
    {
        bf16_t* WPU = (bf16_t*)(ws + WS_WPU);
#pragma unroll 1
        for (int it = gt; it < 128 * 256; it += NGT) {
            const int k0 = (it >> 8) * 4, n4 = (it & 255) * 4, g = k0 >> 7;
            const float* pw = F.pool_w + (size_t)k0 * 128;
            const float* sc = F.pool_scale + g * 128;
            const float* wu = F.w_pool_up + (size_t)(g * 128) * DM + n4;
            f32x4 acc[4];
#pragma unroll
            for (int i = 0; i < 4; ++i) acc[i] = (f32x4){0.f, 0.f, 0.f, 0.f};
#pragma unroll 4
            for (int d = 0; d < 128; ++d) { const f32x4 w4 = *(const f32x4*)(wu + (size_t)d * DM) * sc[d];
#pragma unroll
                for (int i = 0; i < 4; ++i) acc[i] = acc[i] + w4 * pw[128 * i + d]; }
#pragma unroll
            for (int j = 0; j < 4; ++j) { u32x2 o; o.x = pk2(acc[0][j], acc[1][j]); o.y = pk2(acc[2][j], acc[3][j]); *(u32x2*)(WPU + (size_t)(n4 + j) * 512 + k0) = o; }
        }
    }
    {
        bf16_t* KEYS = (bf16_t*)(ws + WS_KEYS);
#pragma unroll 1
        for (int i = gt; i < 2 * 8 * 128 * 128 / 4; i += NGT) {
            const int e = i * 4; const int p = e / (8 * 128 * 128), r = e % (8 * 128 * 128), h = r / (128 * 128), q = r % (128 * 128);
            const f32x4 v = *(const f32x4*)((p ? F.keys2 : F.keys1) + r);
            u32x2 o; o.x = pk2(v[0], v[1]); o.y = pk2(v[2], v[3]);
            *(u32x2*)(KEYS + ((size_t)(h * 2 + p) * 128 * 128 + q)) = o;
        }
    }
    __syncthreads();
    {
        LAS float* wbd = (LAS float*)F.lds;
        for (int i = F.tid; i < 16 * 1024; i += NTHREADS) { const int c = i & 15, k = i >> 4; wbd[c * 1024 + k] = F.w_in[(size_t)k * INC + 4608 + c]; }
        __syncthreads();
        bf16_t* XN = (bf16_t*)F.out; unsigned* XN8 = (unsigned*)(ws + WS_ABUF + 64 * MiB);
        float* BETA = (float*)(ws + WS_BETA); float* GRAW = (float*)(ws + WS_GRAW);
        f32x4 nw[4];
#pragma unroll
        for (int j = 0; j < 4; ++j) nw[j] = *((const f32x4*)F.mix_norm_w + F.lane + 64 * j);
        const int x4 = F.lane & 15, cm = ((x4 & 1) << 3) | ((x4 & 2) << 1) | ((x4 & 4) >> 1) | ((x4 & 8) >> 3), hh = cm & 7;
        const float alog_e = expf(F.a_log[hh]), dtb = F.dt_bias[hh];
        f32x4 vnA[4], vnB[4];
        if (gw < NTOK) { const int gb = (gw + NGW < NTOK) ? gw + NGW : gw;
            const f32x4* xa = (const f32x4*)(F.x + (size_t)gw * DM) + F.lane; const f32x4* xb = (const f32x4*)(F.x + (size_t)gb * DM) + F.lane;
#pragma unroll
            for (int j = 0; j < 4; ++j) { vnA[j] = xa[64 * j]; vnB[j] = xb[64 * j]; } }
#pragma unroll 1
        for (int m = gw; m < NTOK; m += 2 * NGW) {
            const bool hasB = m + NGW < NTOK; const int mB = hasB ? m + NGW : m;
            f32x4 vA[4], vB[4]; float sA = 0.f, sB = 0.f;
#pragma unroll
            for (int j = 0; j < 4; ++j) { vA[j] = vnA[j]; vB[j] = vnB[j];
                sA += (vA[j][0] * vA[j][0] + vA[j][1] * vA[j][1]) + (vA[j][2] * vA[j][2] + vA[j][3] * vA[j][3]);
                sB += (vB[j][0] * vB[j][0] + vB[j][1] * vB[j][1]) + (vB[j][2] * vB[j][2] + vB[j][3] * vB[j][3]); }
            { const int mnA = (m + 2 * NGW < NTOK) ? m + 2 * NGW : m; const int mnB = (mnA + NGW < NTOK) ? mnA + NGW : mnA;
              const f32x4* xa = (const f32x4*)(F.x + (size_t)mnA * DM) + F.lane; const f32x4* xb = (const f32x4*)(F.x + (size_t)mnB * DM) + F.lane;
#pragma unroll
              for (int j = 0; j < 4; ++j) { vnA[j] = xa[64 * j]; vnB[j] = xb[64 * j]; } }
            const float rstdA = __builtin_amdgcn_rsqf(wave_sum_dpp(sA) * (1.f / DM) + EPS);
            const float rstdB = __builtin_amdgcn_rsqf(wave_sum_dpp(sB) * (1.f / DM) + EPS);
            { unsigned long long* o8 = (unsigned long long*)(XN + (size_t)m * DM) + F.lane;
#pragma unroll
              for (int j = 0; j < 4; ++j) { vA[j] = vA[j] * rstdA * nw[j]; o8[64 * j] = (unsigned long long)pk2(vA[j][0], vA[j][1]) | ((unsigned long long)pk2(vA[j][2], vA[j][3]) << 32);
                  XN8[(size_t)m * (DM / 4) + 64 * j + F.lane] = pack4_fp8(vA[j][0], vA[j][1], vA[j][2], vA[j][3], XN8_SCALE); } }
#pragma unroll
            for (int j = 0; j < 4; ++j) vB[j] = vB[j] * rstdB * nw[j];
            if (hasB) { unsigned long long* o8 = (unsigned long long*)(XN + (size_t)mB * DM) + F.lane;
#pragma unroll
              for (int j = 0; j < 4; ++j) { o8[64 * j] = (unsigned long long)pk2(vB[j][0], vB[j][1]) | ((unsigned long long)pk2(vB[j][2], vB[j][3]) << 32);
                  XN8[(size_t)mB * (DM / 4) + 64 * j + F.lane] = pack4_fp8(vB[j][0], vB[j][1], vB[j][2], vB[j][3], XN8_SCALE); } }
            float pdA[16], pdB[16];
#pragma unroll
            for (int c = 0; c < 16; ++c) {
                float a = 0.f, b = 0.f;
#pragma unroll
                for (int j = 0; j < 4; ++j) { const f32x4 w4 = *(const LAS f32x4*)(wbd + c * 1024 + 256 * j + 4 * F.lane);
                    a += (vA[j][0] * w4[0] + vA[j][1] * w4[1]) + (vA[j][2] * w4[2] + vA[j][3] * w4[3]);
                    b += (vB[j][0] * w4[0] + vB[j][1] * w4[1]) + (vB[j][2] * w4[2] + vB[j][3] * w4[3]); }
                pdA[c] = a; pdB[c] = b;
                if (c & 1) asm volatile("" ::: "memory");
            }
            float mineA, mineB;
#define P0_BFLY(pd, mine) do { float q8[8], q4[4], q2[2]; \
            { const bool hi = F.lane & 1; _Pragma("unroll") \
              for (int k = 0; k < 8; ++k) { const float keep = hi ? pd[8 + k] : pd[k], send = hi ? pd[k] : pd[8 + k]; q8[k] = keep + xlane1(send); } } \
            { const bool hi = F.lane & 2; _Pragma("unroll") \
              for (int k = 0; k < 4; ++k) { const float keep = hi ? q8[4 + k] : q8[k], send = hi ? q8[k] : q8[4 + k]; q4[k] = keep + xlane2(send); } } \
            { const bool hi = F.lane & 4; _Pragma("unroll") \
              for (int k = 0; k < 2; ++k) { const float keep = hi ? q4[2 + k] : q4[k], send = hi ? q4[k] : q4[2 + k]; q2[k] = keep + xlane4(send); } } \
            { const bool hi = F.lane & 8; const float keep = hi ? q2[1] : q2[0], send = hi ? q2[0] : q2[1]; mine = keep + xlane8(send); } \
            mine = xsum32(xsum16(mine)); } while (0)
            P0_BFLY(pdA, mineA);
            P0_BFLY(pdB, mineB);
#undef P0_BFLY
            if (F.lane < 16) {
                if (cm < 8) { BETA[(size_t)m * 8 + cm] = 1.0f / (1.0f + expf(-mineA)); if (hasB) BETA[(size_t)mB * 8 + cm] = 1.0f / (1.0f + expf(-mineB)); }
                else { GRAW[(size_t)m * 8 + (cm - 8)] = -alog_e * softplusf_(mineA + dtb); if (hasB) GRAW[(size_t)mB * 8 + (cm - 8)] = -alog_e * softplusf_(mineB + dtb); }
            }
        }
    }
}

template <int WIN> __device__ __forceinline__ void pool_run4(const bf16_t* src, int s0, bf16_t* dst) {
    u32x4 rows[WIN + 3];
#pragma unroll
    for (int k = 0; k < WIN + 3; ++k) { const int d = k - (WIN - 1); rows[k] = (s0 + d >= 0) ? *(const u32x4*)(src + (ptrdiff_t)d * P1N) : (u32x4){0u, 0u, 0u, 0u}; }
    float sum[8];
#pragma unroll
    for (int i = 0; i < 8; ++i) sum[i] = 0.f;
#pragma unroll
    for (int k = 0; k < WIN; ++k) { float f[8]; unpack8(rows[k], f);
#pragma unroll
        for (int i = 0; i < 8; ++i) sum[i] += f[i]; }
#pragma unroll
    for (int j = 0; j < 4; ++j) {
        float cur[8]; unpack8(rows[WIN - 1 + j], cur);
        const int cnt = (s0 + j + 1 < WIN) ? (s0 + j + 1) : WIN; const float inv = __builtin_amdgcn_rcpf((float)cnt);
        float o[8];
#pragma unroll
        for (int i = 0; i < 8; ++i) o[i] = sum[i] * inv - cur[i];
        *(u32x4*)(dst + (size_t)j * 512) = pack8(o);
        if (j < 3) { float fa[8], fs[8]; unpack8(rows[WIN + j], fa); unpack8(rows[j], fs);
#pragma unroll
            for (int i = 0; i < 8; ++i) sum[i] += fa[i] - fs[i]; }
    }
}
__device__ __forceinline__ void p2h_pool(Frame& F) {
    F.fresh();
    const bf16_t* PROJ = (const bf16_t*)(F.ws + WS_PROJ); bf16_t* POOLED = (bf16_t*)(F.ws + WS_POOLED);
    for (int u = F.vcu; u < 512 * 4; u += F.G) {
        const int g = u & 3, tt = u >> 2;
        const int cg = F.tid & 15, run = F.tid >> 4; const int tl0 = 4 * run; const int t = tt * 128 + tl0, s0 = t & (SEQ - 1);
        const bf16_t* src = PROJ + (size_t)t * P1N + C_XA + g * 128 + cg * 8;
        bf16_t* dst = POOLED + (size_t)t * 512 + g * 128 + cg * 8;
        switch (g) { case 0: pool_run4<2>(src, s0, dst); break; case 1: pool_run4<4>(src, s0, dst); break; case 2: pool_run4<8>(src, s0, dst); break; default: pool_run4<16>(src, s0, dst); break; }
    }
}

__device__ __forceinline__ float x16sum(float x) { typedef unsigned u32x2s __attribute__((ext_vector_type(2))); const u32x2s r = __builtin_amdgcn_permlane16_swap(__float_as_uint(x), __float_as_uint(x), false, false); return __uint_as_float(r[0]) + __uint_as_float(r[1]); }
constexpr int Q2_QN = 0, Q2_KN = 17408, Q2_VBT = 34816, Q2_KBGT = 51200, Q2_LM = 67584, Q2_TF = 84992, Q2_TB = 102400, Q2_AST = 111616, Q2_SCAL = 120832, Q2_PART = 121344, Q2_WSCR = 129536;
struct P2Out { bf16_t* qg; bf16_t* kd; bf16_t* uo; int ld; bf16_t* wo; bf16_t* ao; float* gc; size_t tok0; int unit0; int nunits; };
__device__ __forceinline__ void conv_silu4(const u32x2 r0, const u32x2 r1, const u32x2 r2, const u32x2 r3, const float (&wj)[4][4], float* sv) {
    const float x0[4] = {bflo(r0.x), bfhi(r0.x), bflo(r0.y), bfhi(r0.y)}, x1[4] = {bflo(r1.x), bfhi(r1.x), bflo(r1.y), bfhi(r1.y)};
    const float x2[4] = {bflo(r2.x), bfhi(r2.x), bflo(r2.y), bfhi(r2.y)}, x3[4] = {bflo(r3.x), bfhi(r3.x), bflo(r3.y), bfhi(r3.y)};
#pragma unroll
    for (int i = 0; i < 4; ++i) { const float y = (wj[0][i] * x0[i] + wj[1][i] * x1[i]) + (wj[2][i] * x2[i] + wj[3][i] * x3[i]); sv[i] = y * __builtin_amdgcn_rcpf(1.0f + __expf(-y)); }
}
__device__ __forceinline__ int swz8(int row) { return (row ^ (row >> 3)) & 7; }
__device__ __forceinline__ bf16x8 ldfrag_swz(const LAS bf16_t* p, int row0, int k0, int lane) { const int row = row0 + (lane & 15); const int ch = ((k0 >> 3) + (lane >> 4)) ^ swz8(row); return *(const LAS bf16x8*)(p + row * 64 + ch * 8); }
__device__ __forceinline__ f32x4 mfma4f(float a, float b, f32x4 c) { return __builtin_amdgcn_mfma_f32_16x16x4f32(a, b, c, 0, 0, 0); }
__device__ __forceinline__ void tri_block(const LAS float* LM, LAS float* TF, LAS bf16_t* TB, LAS float* scr, int a, int b, int lane) {
    const int fr = lane & 15, fq = lane >> 4;
    f32x4 acc = (f32x4){0.f, 0.f, 0.f, 0.f};
    for (int k = b; k < a; ++k) {
#pragma unroll
        for (int s = 0; s < 4; ++s) acc = mfma4f(LM[(16 * a + fr) * 68 + 16 * k + 4 * s + fq], TF[(16 * k + 4 * s + fq) * 68 + 16 * b + fr], acc);
    }
#pragma unroll
    for (int r = 0; r < 4; ++r) scr[(fq * 4 + r) * 17 + fr] = acc[r];
    LDS_WAIT();
    f32x4 acc2 = (f32x4){0.f, 0.f, 0.f, 0.f};
#pragma unroll
    for (int s = 0; s < 4; ++s) acc2 = mfma4f(TF[(16 * a + fr) * 68 + 16 * a + 4 * s + fq], scr[(4 * s + fq) * 17 + fr], acc2);
#pragma unroll
    for (int r = 0; r < 4; ++r) { const int row = 16 * a + fq * 4 + r, col = 16 * b + fr; const float v = -acc2[r]; TF[row * 68 + col] = v; TB[row * 72 + col] = f2bf(v); }
}
__device__ __forceinline__ void p2_chunk_prep(Frame& F, const P2Out O) {
    F.fresh();
    const bf16_t* PROJ = (const bf16_t*)(F.ws + WS_PROJ); const bf16_t* HALO = (const bf16_t*)(F.ws + WS_HALO);
    const float* BETA = (const float*)(F.ws + WS_BETA); const float* GRAW = (const float*)(F.ws + WS_GRAW);
    LAS bf16_t* QN = (LAS bf16_t*)(F.lds + Q2_QN); LAS bf16_t* KN = (LAS bf16_t*)(F.lds + Q2_KN); LAS bf16_t* VBT = (LAS bf16_t*)(F.lds + Q2_VBT); LAS bf16_t* KBGT = (LAS bf16_t*)(F.lds + Q2_KBGT);
    LAS float* LM = (LAS float*)(F.lds + Q2_LM); LAS float* TF = (LAS float*)(F.lds + Q2_TF); LAS bf16_t* TB = (LAS bf16_t*)(F.lds + Q2_TB); LAS bf16_t* AST = (LAS bf16_t*)(F.lds + Q2_AST);
    LAS float* SBETA = (LAS float*)(F.lds + Q2_SCAL); LAS float* SGC = SBETA + 64; LAS float* SFQ = (LAS float*)(F.lds + Q2_PART); LAS float* SFK = SFQ + 64; LAS float* SF2 = SFQ + 128;
    const int tid = F.tid, lane = F.lane, w = F.wave;
    LAS float* scr = (LAS float*)(F.lds + Q2_WSCR) + w * 272;
    const float scale = 0.08838834764831845f;
    const int typ = (w < 4) ? (w >> 1) : 2, cc = tid & 31;
    const int tokb = (w < 4) ? 16 * ((tid & 127) >> 5) : 8 * ((tid - 256) >> 5), ng4 = (w < 4) ? 4 : 2;
    for (int i = tid; i < 64 * 72 / 2; i += NTHREADS) ((LAS unsigned*)TB)[i] = 0u;
    u32x2 raw[19]; float pbeta = 0.f, pg = 0.f;
#define P2_LOAD(uu) do { const int h_ = (uu) & 7, bn_ = (uu) >> 3, n_ = bn_ % NCHUNK, b_ = bn_ / NCHUNK; const size_t t0_ = (size_t)b_ * SEQ + (size_t)n_ * 64; \
        { const int col_ = C_Q + typ * 1024 + h_ * 128 + cc * 4; int tokb_ = tokb; asm volatile("" : "+v"(tokb_));     \
            \
          _Pragma("unroll") for (int rr = 0; rr < 3; ++rr) { const bf16_t* p_ = (tokb_ == 0) ? HALO + ((size_t)bn_ * 3 + rr) * 3072 + (col_ - C_Q) : PROJ + (t0_ + tokb_ - 3 + rr) * P1N + col_; \
              if (tokb_ == 0 && n_ == 0) raw[rr] = (u32x2){0u, 0u}; else raw[rr] = *(const u32x2*)p_; }     \
          { const bf16_t* pb_ = PROJ + (t0_ + tokb_) * P1N + col_; \
            if (w < 4) { _Pragma("unroll") for (int rr = 3; rr < 19; ++rr) raw[rr] = *(const u32x2*)(pb_ + (size_t)(rr - 3) * P1N); } \
            else { _Pragma("unroll") for (int rr = 3; rr < 11; ++rr) raw[rr] = *(const u32x2*)(pb_ + (size_t)(rr - 3) * P1N); } } } \
        if (w == 7) { pbeta = BETA[(t0_ + lane) * 8 + h_]; pg = GRAW[(t0_ + lane) * 8 + h_]; } } while (0)
    const size_t TNGT = (size_t)F.G * NTHREADS; constexpr size_t TB_TOT = (size_t)16384 * 1024 / 4;
    const int TB_N = (int)((TB_TOT + TNGT - 1) / TNGT); int tb_it = 0;
    f32x4 td_ = (f32x4){0.f, 0.f, 0.f, 0.f}, tu_ = td_; bool tv_ = false;
#define P2_TBL_ISSUE() do { int tq_ = threadIdx.x; asm volatile("" : "+v"(tq_)); const size_t i_ = (size_t)F.vcu * NTHREADS + tq_ + (size_t)tb_it * TNGT; tv_ = (tb_it < TB_N) && (i_ < TB_TOT); \
        if (tv_) { td_ = *(const f32x4*)(F.peer_down + i_ * 4); tu_ = *(const f32x4*)(F.peer_up + i_ * 4); } } while (0)
#define P2_TBL_FINISH() do { if (tv_) { int tq_ = threadIdx.x; asm volatile("" : "+v"(tq_)); const size_t i_ = (size_t)F.vcu * NTHREADS + tq_ + (size_t)tb_it * TNGT; const size_t e_ = i_ * 4; const int k_ = (int)(e_ & 1023); \
            const f32x4 nw_ = *(const f32x4*)(F.ffn_norm_w + k_); const f32x4 d_ = td_ * nw_ * ED_SCALE, u_ = tu_ * EU_SCALE; \
            const size_t di_ = ((size_t)(k_ >> 7) * (16384 * 128) + (e_ >> 10) * 128 + (k_ & 127)) >> 2; \
            ((unsigned*)(F.ws + WS_EDOWN))[di_] = pack4_fp8(d_[0], d_[1], d_[2], d_[3], 1.0f); ((unsigned*)(F.ws + WS_EUP))[di_] = pack4_fp8(u_[0], u_[1], u_[2], u_[3], 1.0f); } \
        ++tb_it; } while (0)
    const int u_end = O.unit0 + O.nunits;
    int u = O.unit0 + F.vcu;
    if (u < u_end) P2_LOAD(u);
    for (; u < u_end; u += F.G) {
        const int h = u & 7, bn = u >> 3, n = bn % NCHUNK, b = bn / NCHUNK; const size_t t0 = (size_t)b * SEQ + (size_t)n * 64; const size_t tr0 = t0 - O.tok0;
        const int col = C_Q + typ * 1024 + h * 128 + cc * 4;
        VM_WAIT();
        if (w == 7) {
            float g = pg;
            { }
            g += __int_as_float(__builtin_amdgcn_update_dpp(0, __float_as_int(g), 0x111, 0xF, 0xF, true)); g += __int_as_float(__builtin_amdgcn_update_dpp(0, __float_as_int(g), 0x112, 0xF, 0xF, true));
            g += __int_as_float(__builtin_amdgcn_update_dpp(0, __float_as_int(g), 0x114, 0xF, 0xF, true)); g += __int_as_float(__builtin_amdgcn_update_dpp(0, __float_as_int(g), 0x118, 0xF, 0xF, true));
            g += __int_as_float(__builtin_amdgcn_update_dpp(0, __float_as_int(g), 0x142, 0xA, 0xF, false)); g += __int_as_float(__builtin_amdgcn_update_dpp(0, __float_as_int(g), 0x143, 0xC, 0xF, false));
            SBETA[lane] = pbeta; SGC[lane] = g; O.gc[(tr0 + lane) * 8 + h] = g;
            { const float eg = __expf(g), glast = __int_as_float(__builtin_amdgcn_readlane(__float_as_int(g), 63)); SFQ[lane] = scale * eg; SFK[lane] = __expf(glast - g); SF2[lane] = pbeta * eg; }
        }
        float wj[4][4];
        {
#pragma unroll
            for (int j = 0; j < 4; ++j) { const f32x4 a = *(const f32x4*)(F.conv_w + (size_t)j * 3072 + (col - C_Q)); wj[j][0] = a[0]; wj[j][1] = a[1]; wj[j][2] = a[2]; wj[j][3] = a[3]; }
        }
        __syncthreads();
        {
            LAS bf16_t* lrow = ((typ == 0) ? QN : KN) + tokb * 136 + cc * 4;
            bf16_t* grow = ((typ == 0) ? O.qg : O.kd) + (tr0 + tokb) * O.ld + h * 128 + cc * 4;
            const LAS float* sb = ((typ == 2) ? SBETA : SF2) + tokb; const LAS float* sg = ((typ == 0) ? SFQ : SFK) + tokb;
            LAS bf16_t* dst = (typ == 1) ? KBGT : VBT;
#pragma unroll 1
            for (int g4 = 0; g4 < ng4; ++g4) {
                unsigned xp[2][4]; float xe[4];
                float xr[7][4];
#pragma unroll
                for (int q7 = 0; q7 < 7; ++q7) { xr[q7][0] = bflo(raw[q7].x); xr[q7][1] = bfhi(raw[q7].x); xr[q7][2] = bflo(raw[q7].y); xr[q7][3] = bfhi(raw[q7].y); }
#pragma unroll
                for (int t4 = 0; t4 < 4; ++t4) {
                    float sv[4];
#pragma unroll
                    for (int i = 0; i < 4; ++i) { const float y = (wj[0][i] * xr[t4][i] + wj[1][i] * xr[t4 + 1][i]) + (wj[2][i] * xr[t4 + 2][i] + wj[3][i] * xr[t4 + 3][i]); sv[i] = y * __builtin_amdgcn_rcpf(1.0f + __expf(-y)); }
                    const float be = sb[t4];
                    float xo[4];
                    if (typ < 2) {
                        float tot = (sv[0] * sv[0] + sv[1] * sv[1]) + (sv[2] * sv[2] + sv[3] * sv[3]);
                        tot += dpp_f<0xB1>(tot); tot += dpp_f<0x4E>(tot); tot += dpp_f<0x141>(tot); tot += dpp_f<0x140>(tot); tot = x16sum(tot);
                        const float rn = __builtin_amdgcn_rsqf(tot + EPS);
                        float nv[4], ov[4];
#pragma unroll
                        for (int i = 0; i < 4; ++i) nv[i] = sv[i] * rn;
                        { u32x2 v; v.x = pk2(nv[0], nv[1]); v.y = pk2(nv[2], nv[3]); *(LAS u32x2*)lrow = v; }
                        const float f = sg[t4], f2 = be;
#pragma unroll
                        for (int i = 0; i < 4; ++i) { ov[i] = nv[i] * f; xo[i] = nv[i] * f2; }
                        { u32x2 v; v.x = pk2(ov[0], ov[1]); v.y = pk2(ov[2], ov[3]); *(u32x2*)grow = v; }
                        lrow += 136; grow += O.ld;
                    } else {
#pragma unroll
                        for (int i = 0; i < 4; ++i) xo[i] = sv[i] * be;
                    }
                    if (t4 & 1) {
#pragma unroll
                        for (int i = 0; i < 4; ++i) xp[t4 >> 1][i] = pk2(xe[i], xo[i]);
                    } else {
#pragma unroll
                        for (int i = 0; i < 4; ++i) xe[i] = xo[i];
                    }
                }
                if (typ >= 1) {
                    const int tk = tokb + 4 * g4;
#pragma unroll
                    for (int i = 0; i < 4; ++i) { const int row = cc * 4 + i; u32x2 v; v.x = xp[0][i]; v.y = xp[1][i];
                        *(LAS u32x2*)(dst + row * 64 + (((tk >> 3) ^ swz8(row)) * 8) + (tk & 4)) = v; }
                }
#pragma unroll
                for (int i = 0; i < 15; ++i) raw[i] = raw[i + 4];
                sb += 4; sg += 4;
            }
        }
        if (u + F.G < u_end) P2_LOAD(u + F.G);
        P2_TBL_ISSUE();
        __syncthreads();
        {
            const int mi = w & 3; const bool isq = w >= 4;
            f32x4 acc[4];
#pragma unroll
            for (int ni = 0; ni < 4; ++ni) acc[ni] = (f32x4){0.f, 0.f, 0.f, 0.f};
#pragma unroll
            for (int k0 = 0; k0 < 128; k0 += 32) { const bf16x8 a = ldfrag(isq ? QN : KN, 136, mi * 16, k0, lane);
#pragma unroll
                for (int ni = 0; ni < 4; ++ni) acc[ni] = mfma16(a, ldfrag(KN, 136, ni * 16, k0, lane), acc[ni]); }
            float gi[4], bi[4], gj[4];
#pragma unroll
            for (int r = 0; r < 4; ++r) { gi[r] = SGC[mi * 16 + (lane >> 4) * 4 + r]; bi[r] = SBETA[mi * 16 + (lane >> 4) * 4 + r]; gj[r] = SGC[r * 16 + (lane & 15)]; }
#pragma unroll
            for (int ni = 0; ni < 4; ++ni)
#pragma unroll
                for (int r = 0; r < 4; ++r) { const int i = mi * 16 + (lane >> 4) * 4 + r, j = ni * 16 + (lane & 15);
                    const float dec = __expf(fminf(gi[r] - gj[ni], 0.f));
                    if (!isq) LM[i * 68 + j] = (i > j) ? bi[r] * acc[ni][r] * dec : 0.f;
                    else AST[i * 72 + j] = f2bf((i >= j) ? acc[ni][r] * scale * dec : 0.f); }
        }
        __syncthreads();
        { const int row = tid >> 3, ch = tid & 7; *(u32x4*)(O.ao + (size_t)(u - O.unit0) * 4096 + row * 64 + ch * 8) = *(const LAS u32x4*)(AST + row * 72 + ch * 8); }
        if (w < 4) {
            const int a = w, c = lane & 15;
            float Lr[16];
#pragma unroll
            for (int q = 0; q < 4; ++q) { const f32x4 l4 = *(const LAS f32x4*)(LM + (16 * a + c) * 68 + 16 * a + q * 4); Lr[4 * q] = l4[0]; Lr[4 * q + 1] = l4[1]; Lr[4 * q + 2] = l4[2]; Lr[4 * q + 3] = l4[3]; }
            float tc[16];
#pragma unroll
            for (int i = 0; i < 16; ++i) {
                float s = (i == c) ? 1.f : 0.f;
#pragma unroll
                for (int j = 0; j < i; ++j) s -= __int_as_float(__builtin_amdgcn_readlane(__float_as_int(Lr[j]), i)) * tc[j];
                tc[i] = s;
                if (lane < 16) { TF[(16 * a + i) * 68 + 16 * a + c] = s; TB[(16 * a + i) * 72 + 16 * a + c] = f2bf(s); }
            }
        }
        __syncthreads();
        if (w < 3) tri_block(LM, TF, TB, scr, w + 1, w, lane);
        __syncthreads();
        if (w < 2) tri_block(LM, TF, TB, scr, w + 2, w, lane);
        __syncthreads();
        if (w == 0) tri_block(LM, TF, TB, scr, 3, 0, lane);
        __syncthreads();
#ifdef P2_CHECK
        if (w == 0) {
            LAS float* T2 = (LAS float*)(F.lds + Q2_AST);
            float md = 0.f;
            for (int i = 0; i < 64; ++i) {
                float s = (i == lane) ? 1.f : 0.f;
                for (int j = 0; j < i; ++j) s -= LM[i * 68 + j] * T2[j * 65 + lane];
                T2[i * 65 + lane] = s;
                if (i >= lane) md = fmaxf(md, fabsf(s - TF[i * 68 + lane]));
            }
#pragma unroll
            for (int o = 1; o < 64; o <<= 1) md = fmaxf(md, __shfl_xor(md, o));
            if (lane == 0) atomicMax((unsigned*)(F.ws + 64), __float_as_uint(md));
        }
        __syncthreads();
#endif
        {
            f32x4 au[4], aw[4];
#pragma unroll
            for (int mi = 0; mi < 4; ++mi) { au[mi] = (f32x4){0.f, 0.f, 0.f, 0.f}; aw[mi] = (f32x4){0.f, 0.f, 0.f, 0.f}; }
#pragma unroll
            for (int k0 = 0; k0 < 64; k0 += 32) { const bf16x8 bv = ldfrag_swz(VBT, w * 16, k0, lane), bk = ldfrag_swz(KBGT, w * 16, k0, lane);
#pragma unroll
                for (int mi = 0; mi < 4; ++mi) { const bf16x8 a = ldfrag(TB, 72, mi * 16, k0, lane); au[mi] = mfma16(a, bv, au[mi]); aw[mi] = mfma16(a, bk, aw[mi]); } }
            const int cl = w * 16 + (lane & 15);
#pragma unroll
            for (int mi = 0; mi < 4; ++mi)
#pragma unroll
                for (int r = 0; r < 4; ++r) { const int i = mi * 16 + (lane >> 4) * 4 + r; QN[i * 136 + cl] = f2bf(au[mi][r]); KN[i * 136 + cl] = f2bf(aw[mi][r]); }
        }
        __syncthreads();
#pragma unroll
        for (int q = tid; q < 1024; q += NTHREADS) { const int row = q >> 4, ch = q & 15;
            *(u32x4*)(O.uo + (tr0 + row) * O.ld + h * 128 + ch * 8) = *(const LAS u32x4*)(QN + row * 136 + ch * 8);
            *(u32x4*)(O.wo + (tr0 + row) * DM + h * 128 + ch * 8) = *(const LAS u32x4*)(KN + row * 136 + ch * 8); }
        P2_TBL_FINISH();
    }
#pragma unroll 1
    while (tb_it < TB_N) { P2_TBL_ISSUE(); P2_TBL_FINISH(); }
#undef P2_TBL_ISSUE
#undef P2_TBL_FINISH
#undef P2_LOAD
}

constexpr int P3_WC = 0, P3_QGC = 17408, P3_UC = 34816  , P3_KDT = 39936  , P3_AC = 72704  , P3_SBT = 91136, P3_VNT = 99840, P3_OT = 104448  ;
__device__ __forceinline__ void p3_scan(Frame& F) {
    F.fresh();
    bf16_t* PROJ = (bf16_t*)(F.ws + WS_PROJ); const bf16_t* WBUF = (const bf16_t*)(F.ws + WS_WBUF); const bf16_t* ABUF = (const bf16_t*)(F.ws + WS_ABUF); const float* GC = (const float*)(F.ws + WS_GC);
    LAS bf16_t* WC = (LAS bf16_t*)(F.lds + P3_WC); LAS bf16_t* QGC = (LAS bf16_t*)(F.lds + P3_QGC); LAS bf16_t* UC = (LAS bf16_t*)(F.lds + P3_UC);
    LAS bf16_t* SBT = (LAS bf16_t*)(F.lds + P3_SBT); LAS bf16_t* VNT = (LAS bf16_t*)(F.lds + P3_VNT); LAS bf16_t* OT = (LAS bf16_t*)(F.lds + P3_OT);
    const int tid = F.tid, lane = F.lane, w = F.wave;
    for (int u = F.vcu; u < NBATCH * 8 * 4; u += F.G) {
        const int sl = u & 3, h = (u >> 2) & 7, b = u >> 5;
        __syncthreads();
        for (int i = tid; i < 32 * 136; i += NTHREADS) SBT[i] = 0;
        f32x4 accS[2]; accS[0] = (f32x4){0.f, 0.f, 0.f, 0.f}; accS[1] = (f32x4){0.f, 0.f, 0.f, 0.f};
        const int r0 = tid >> 4, c0 = tid & 15;
        const int ra = tid >> 3, ca = tid & 7;
        const int ru = (tid & 255) >> 2, cu = tid & 3;
        u32x4 pw[2][2], pq[2][2], pa[2], pu[2]; u32x2 pk[2][4]; float pgl[2];
        const int kc4 = tid & 31, krg = tid >> 5;
#define P3_LOAD_A(nn, S) do { const size_t tt0 = (size_t)b * SEQ + (size_t)(nn) * 64; \
            _Pragma("unroll") for (int k = 0; k < 2; ++k) { const size_t row = tt0 + r0 + 32 * k; \
                pw[S][k] = *(const u32x4*)(WBUF + row * DM + h * 128 + c0 * 8); pq[S][k] = *(const u32x4*)(PROJ + row * P1N + C_Q + h * 128 + c0 * 8); } } while (0)
#define P3_LOAD_B(nn, S) do { const size_t tt0 = (size_t)b * SEQ + (size_t)(nn) * 64; \
            _Pragma("unroll") for (int k = 0; k < 4; ++k) pk[S][k] = *(const u32x2*)(PROJ + (tt0 + 4 * krg + k) * P1N + C_K + h * 128 + kc4 * 4); } while (0)
#define P3_LOAD_C(nn, S) do { const size_t tt0 = (size_t)b * SEQ + (size_t)(nn) * 64; \
            pa[S] = *(const u32x4*)(ABUF + ((size_t)(b * NCHUNK + (nn)) * 8 + h) * 4096 + ra * 64 + ca * 8); \
            if (tid < 256) pu[S] = *(const u32x4*)(PROJ + (tt0 + ru) * P1N + C_V + h * 128 + sl * 32 + cu * 8); \
            pgl[S] = GC[(tt0 + 63) * 8 + h]; } while (0)
#define P3_LOAD(nn, S) do { P3_LOAD_A(nn, S); P3_LOAD_B(nn, S); P3_LOAD_C(nn, S); } while (0)
#define P3_FILL(bufi, S) do { LAS bf16_t* KDTn = (LAS bf16_t*)(F.lds + P3_KDT + (bufi) * 16384); LAS bf16_t* ACn = (LAS bf16_t*)(F.lds + P3_AC + (bufi) * 9216); \
            _Pragma("unroll") for (int k = 0; k < 2; ++k) { const int row = r0 + 32 * k; \
                *(LAS u32x4*)(WC + row * 136 + c0 * 8) = pw[S][k]; *(LAS u32x4*)(QGC + row * 136 + c0 * 8) = pq[S][k]; } \
            _Pragma("unroll") for (int i = 0; i < 4; ++i) { const int d_ = 4 * kc4 + i; \
                const unsigned s0_ = (i < 2 ? pk[S][0].x : pk[S][0].y), s1_ = (i < 2 ? pk[S][1].x : pk[S][1].y), s2_ = (i < 2 ? pk[S][2].x : pk[S][2].y), s3_ = (i < 2 ? pk[S][3].x : pk[S][3].y); \
                const unsigned sel_ = (i & 1) ? 0x07060302u : 0x05040100u;         \
                u32x2 o_; o_.x = __builtin_amdgcn_perm(s1_, s0_, sel_); o_.y = __builtin_amdgcn_perm(s3_, s2_, sel_); \
                *(LAS u32x2*)(KDTn + d_ * 64 + (((krg >> 1) ^ swz8(d_)) * 8) + 4 * (krg & 1)) = o_; } \
            *(LAS u32x4*)(ACn + ra * 72 + ca * 8) = pa[S]; \
            if (tid < 256) *(LAS u32x4*)(UC + ru * 40 + cu * 8) = pu[S]; } while (0)
#define P3_STEP(n_, cur_) do { const int n = (n_); \
            const size_t t0 = (size_t)b * SEQ + (size_t)n * 64; \
            const LAS bf16_t* KDT = (const LAS bf16_t*)(F.lds + P3_KDT + (cur_) * 16384); const LAS bf16_t* AC = (const LAS bf16_t*)(F.lds + P3_AC + (cur_) * 9216); \
            if (n >= 1 && tid < 256) *(u32x4*)(PROJ + (t0 - 64 + ru) * P1N + C_V + h * 128 + sl * 32 + cu * 8) = *(const LAS u32x4*)(OT + ru * 40 + cu * 8); \
              \
            const int mi = w >> 1, ni = w & 1; \
            f32x4 ax = (f32x4){0.f, 0.f, 0.f, 0.f}, ay = (f32x4){0.f, 0.f, 0.f, 0.f}; \
            _Pragma("unroll") for (int k0 = 0; k0 < 128; k0 += 32) { const bf16x8 bs = ldfrag(SBT, 136, ni * 16, k0, lane); \
                ax = mfma16(ldfrag(WC, 136, mi * 16, k0, lane), bs, ax); ay = mfma16(ldfrag(QGC, 136, mi * 16, k0, lane), bs, ay); } \
            const int e = ni * 16 + (lane & 15); \
            _Pragma("unroll") for (int r = 0; r < 4; ++r) { const int i = mi * 16 + (lane >> 4) * 4 + r; VNT[e * 72 + i] = f2bf(bf2f(UC[i * 40 + e]) - ax[r]); } \
            __builtin_amdgcn_sched_barrier(0); \
            if (n >= 1 && n + 2 < NCHUNK) P3_LOAD_B(n + 2, (cur_)); \
            __syncthreads();                                                     \
            float egl_next = egl; \
            if (n + 1 < NCHUNK) { P3_FILL((cur_) ^ 1, (cur_) ^ 1); egl_next = __expf(pgl[(cur_) ^ 1]); }    \
              \
            _Pragma("unroll") for (int k0 = 0; k0 < 64; k0 += 32) ay = mfma16(ldfrag(AC, 72, mi * 16, k0, lane), ldfrag(VNT, 72, ni * 16, k0, lane), ay); \
            _Pragma("unroll") for (int r = 0; r < 4; ++r) { const int i = mi * 16 + (lane >> 4) * 4 + r; OT[i * 40 + e] = f2bf(ay[r]); }     \
              \
            _Pragma("unroll") for (int mt = 0; mt < 2; ++mt) { accS[mt] = accS[mt] * egl; \
                _Pragma("unroll") for (int k0 = 0; k0 < 64; k0 += 32) accS[mt] = mfma16(ldfrag(VNT, 72, mt * 16, k0, lane), ldfrag_swz(KDT, w * 16, k0, lane), accS[mt]); \
                _Pragma("unroll") for (int r = 0; r < 4; ++r) SBT[(mt * 16 + (lane >> 4) * 4 + r) * 136 + w * 16 + (lane & 15)] = f2bf(accS[mt][r]); } \
              \
            __builtin_amdgcn_sched_barrier(0); \
            if (n + 3 < NCHUNK) { P3_LOAD_A(n + 3, (cur_) ^ 1); P3_LOAD_C(n + 3, (cur_) ^ 1); } \
            egl = egl_next; \
            __syncthreads();                                                     \
        } while (0)
        P3_LOAD(0, 0);
        P3_FILL(0, 0);
        float egl = __expf(pgl[0]);
        __syncthreads();
        P3_LOAD(1, 1); P3_LOAD(2, 0);
#pragma unroll 1
        for (int n2 = 0; n2 < NCHUNK; n2 += 2) { P3_STEP(n2, 0); P3_STEP(n2 + 1, 1); }
        if (tid < 256) *(u32x4*)(PROJ + ((size_t)b * SEQ + (size_t)(NCHUNK - 1) * 64 + ru) * P1N + C_V + h * 128 + sl * 32 + cu * 8) = *(const LAS u32x4*)(OT + ru * 40 + cu * 8);
#undef P3_STEP
#undef P3_LOAD
#undef P3_LOAD_A
#undef P3_LOAD_B
#undef P3_LOAD_C
#undef P3_FILL
    }
}

__device__ __forceinline__ void p4_gated_norm(Frame& F) {
    F.fresh();
    bf16_t* PROJ = (bf16_t*)(F.ws + WS_PROJ);
    const int gt = F.vcu * NTHREADS + F.tid, NGT = F.G * NTHREADS;
    const int sub = F.lane & 15;
    float nw[8];
    { const f32x4 a = *(const f32x4*)(F.dn_norm_w + sub * 8), bq = *(const f32x4*)(F.dn_norm_w + sub * 8 + 4); nw[0] = a[0]; nw[1] = a[1]; nw[2] = a[2]; nw[3] = a[3]; nw[4] = bq[0]; nw[5] = bq[1]; nw[6] = bq[2]; nw[7] = bq[3]; }
    constexpr int NIT = NTOK * 8 * 16;
#define P4_ADDR(i_, po_, pz_, dst_) const int th##i_ = (i_) >> 4, t##i_ = th##i_ >> 3, h##i_ = th##i_ & 7; \
        const bf16_t* po_ = PROJ + (size_t)t##i_ * P1N + C_V + h##i_ * 128 + sub * 8; const bf16_t* pz_ = PROJ + (size_t)t##i_ * P1N + C_Z + h##i_ * 128 + sub * 8; \
        unsigned char* dst_ = (unsigned char*)F.out + (size_t)t##i_ * DM + h##i_ * 128 + sub * 8
#define P4_ITEM(ro_, rz_, dst_) do { float o[8], z[8]; unpack8(ro_, o); unpack8(rz_, z); \
        float s = 0.f; \
        _Pragma("unroll") for (int k = 0; k < 8; ++k) s += o[k] * o[k]; \
        s += dpp_f<0xB1>(s); s += dpp_f<0x4E>(s); s += dpp_f<0x141>(s); s += dpp_f<0x140>(s);     \
        const float rstd = __builtin_amdgcn_rsqf(s * (1.f / 128.f) + EPS); \
        _Pragma("unroll") for (int k = 0; k < 8; ++k) { const float zz = z[k]; o[k] = o[k] * rstd * nw[k] * (zz * __builtin_amdgcn_rcpf(1.0f + __expf(-zz))); } \
        { const unsigned v0 = pack4_fp8(o[0], o[1], o[2], o[3], ON8_SCALE), v1 = pack4_fp8(o[4], o[5], o[6], o[7], ON8_SCALE); \
          u32x2 o8; o8.x = v0; o8.y = v1; *(u32x2*)(dst_) = o8; } } while (0)
#pragma unroll 1
    for (int i = gt; i < NIT; i += 2 * NGT) {
        const int ia = i; const bool hasB = i + NGT < NIT; const int ib = hasB ? i + NGT : i;
        P4_ADDR(ia, poA, pzA, dA); P4_ADDR(ib, poB, pzB, dB);
        const u32x4 roA = *(const u32x4*)poA, rzA = *(const u32x4*)pzA, roB = *(const u32x4*)poB, rzB = *(const u32x4*)pzB;
        P4_ITEM(roA, rzA, dA);
        if (hasB) P4_ITEM(roB, rzB, dB);
    }
#undef P4_ADDR
#undef P4_ITEM
}

typedef float f32x2v __attribute__((ext_vector_type(2)));
typedef unsigned u32x2v __attribute__((ext_vector_type(2)));
constexpr int P10_KS = 0  , P10_WV = 69632  , P10_LV = 0  , P10_LI = 2304  ,
              P10_OV = 4608  , P10_OC = 5888  , P10_WVSZ = 7168;
template <int CTRL> __device__ __forceinline__ int dpp_i(int v) { return __builtin_amdgcn_update_dpp(0, v, CTRL, 0xF, 0xF, false); }
__device__ __forceinline__ float gmax16(float m) { m = fmaxf(m, __int_as_float(dpp_i<0xB1>(__float_as_int(m)))); m = fmaxf(m, __int_as_float(dpp_i<0x4E>(__float_as_int(m))));
    m = fmaxf(m, __int_as_float(dpp_i<0x141>(__float_as_int(m)))); m = fmaxf(m, __int_as_float(dpp_i<0x140>(__float_as_int(m)))); return m; }
__device__ __forceinline__ float gsumf16(float s) { s += __int_as_float(dpp_i<0xB1>(__float_as_int(s))); s += __int_as_float(dpp_i<0x4E>(__float_as_int(s)));
    s += __int_as_float(dpp_i<0x141>(__float_as_int(s))); s += __int_as_float(dpp_i<0x140>(__float_as_int(s))); return s; }
__device__ __forceinline__ float q4sum(float x) { u32x2v r = __builtin_amdgcn_permlane32_swap(__float_as_uint(x), __float_as_uint(x), false, false); x = __uint_as_float(r[0]) + __uint_as_float(r[1]);
    r = __builtin_amdgcn_permlane16_swap(__float_as_uint(x), __float_as_uint(x), false, false); return __uint_as_float(r[0]) + __uint_as_float(r[1]); }
__device__ __forceinline__ float q4max(float x) { u32x2v r = __builtin_amdgcn_permlane32_swap(__float_as_uint(x), __float_as_uint(x), false, false); x = fmaxf(__uint_as_float(r[0]), __uint_as_float(r[1]));
    r = __builtin_amdgcn_permlane16_swap(__float_as_uint(x), __float_as_uint(x), false, false); return fmaxf(__uint_as_float(r[0]), __uint_as_float(r[1])); }
__device__ __forceinline__ float q4min(float x) { u32x2v r = __builtin_amdgcn_permlane32_swap(__float_as_uint(x), __float_as_uint(x), false, false); x = fminf(__uint_as_float(r[0]), __uint_as_float(r[1]));
    r = __builtin_amdgcn_permlane16_swap(__float_as_uint(x), __float_as_uint(x), false, false); return fminf(__uint_as_float(r[0]), __uint_as_float(r[1])); }
__device__ __forceinline__ int q4x16(int x, int g) { const u32x2v r = __builtin_amdgcn_permlane16_swap((unsigned)x, (unsigned)x, false, false); return (int)((g & 1) ? r[0] : r[1]); }
__device__ __forceinline__ int q4x32(int x, int g) { const u32x2v r = __builtin_amdgcn_permlane32_swap((unsigned)x, (unsigned)x, false, false); return (int)((g & 2) ? r[0] : r[1]); }
__device__ __forceinline__ int q4prefix(int x, int g) { const int x1 = q4x16(x, g), x2 = q4x32(x, g), x3 = q4x32(x1, g); return ((g & 1) ? x1 : 0) + ((g & 2) ? x2 + x3 : 0); }
__device__ __forceinline__ int q4total(int x, int g) { const int x1 = q4x16(x, g); const int s = x + x1; return s + q4x32(s, g); }
__device__ __forceinline__ f32x2v pk_above(f32x2v v, f32x2v big, f32x2v nmid) { f32x2v r; asm("v_pk_fma_f32 %0, %1, %2, %3 clamp" : "=v"(r) : "v"(v), "v"(big), "v"(nmid)); return r; }
constexpr float P10_BIG = 0x1p100f;
template <int NP> __device__ __forceinline__ float p10_count(const f32x2v (&V)[NP], float mid) {
    const f32x2v big = {P10_BIG, P10_BIG}; const float nm = -mid * P10_BIG; const f32x2v nmid = {nm, nm};
    f32x2v a = {0.f, 0.f}, b = {0.f, 0.f};
#pragma unroll
    for (int i = 0; i < NP; i += 2) { a += pk_above(V[i], big, nmid); b += pk_above(V[i + 1], big, nmid); }
    const f32x2v s = a + b; return s[0] + s[1];
}
template <int STAGE> __device__ __forceinline__ constexpr int p10_code(int i, int e) { return STAGE == 1 ? 16 * (i >> 1) + 2 * (i & 1) + e : 2 * i + e; }
template <int NP, int STAGE> __device__ __forceinline__ void p10_emit_fast(const f32x2v (&V)[NP], float thr, unsigned pos, unsigned dump, LAS unsigned char* vb, LAS unsigned char* ib, int code0) {
#pragma unroll
    for (int i = 0; i < NP; ++i)
#pragma unroll
        for (int e = 0; e < 2; ++e) { const float val = V[i][e]; const bool c = val > thr; const unsigned a = c ? pos : dump;
            *(LAS float*)(vb + a) = val; *(LAS int*)(ib + a) = code0 | p10_code<STAGE>(i, e); pos += c ? 4u : 0u; __builtin_amdgcn_sched_barrier(0); }
}
template <int NP, int STAGE> __device__ __forceinline__ void p10_emit_general(const f32x2v (&V)[NP], float lo, float hi, int g, unsigned lb, unsigned dump, LAS unsigned char* vb, LAS unsigned char* ib, int code0) {
    int na = 0, nt = 0;
#pragma unroll
    for (int i = 0; i < NP; ++i)
#pragma unroll
        for (int e = 0; e < 2; ++e) { const float val = V[i][e]; const bool a = val > hi, t = (val > lo) && !a; na += a ? 1 : 0; nt += t ? 1 : 0; __builtin_amdgcn_sched_barrier(0); }
    const int H = q4total(na, g), tpre = q4prefix(nt, g);
    const int take = min(nt, max(0, 16 - H - tpre));
    const int base = q4prefix(na + take, g);
    unsigned pos = lb + 4u * (unsigned)base; int trank = 0;
    asm volatile("" : "+v"(lo), "+v"(hi));
#pragma unroll
    for (int i = 0; i < NP; ++i)
#pragma unroll
        for (int e = 0; e < 2; ++e) { const float val = V[i][e]; const bool a = val > hi, t = (val > lo) && !a; const bool c = a || (t && trank < take); trank += t ? 1 : 0;
            const unsigned ad = c ? pos : dump; *(LAS float*)(vb + ad) = val; *(LAS int*)(ib + ad) = code0 | p10_code<STAGE>(i, e); pos += c ? 4u : 0u; __builtin_amdgcn_sched_barrier(0); }
}
__device__ __forceinline__ void p10_topk(Frame& F) {
    F.fresh();
    const bf16_t* Q2 = (const bf16_t*)(F.ws + WS_Q2); const bf16_t* KEYS = (const bf16_t*)(F.ws + WS_KEYS); int* IDX = (int*)(F.ws + WS_IDX); float* GATEW = (float*)(F.ws + WS_GATEW);
    LAS bf16_t* KS = (LAS bf16_t*)(F.lds + P10_KS);
    const int tid = F.tid, lane = F.lane, w = F.wave, tok = lane & 15, g = lane >> 4;
    LAS unsigned char* WV = F.lds + P10_WV + w * P10_WVSZ;
    LAS unsigned char* LVb = WV + P10_LV; LAS unsigned char* LIb = WV + P10_LI; LAS unsigned char* OVb = WV + P10_OV; LAS unsigned char* OCb = WV + P10_OC;
    const int NSU = (NTOK / 256) * 8;
    int cur_h = -1;
    bf16x8 qf[2][4];
#define P10_LOADQ(su_, j_) do { const bf16_t* qp_ = Q2 + (size_t)(((su_) >> 3) * 256 + (2 * w + (j_)) * 16 + tok) * 2048 + ((su_) & 7) * 256 + 8 * g; \
        _Pragma("unroll") for (int p_ = 0; p_ < 2; ++p_) _Pragma("unroll") for (int ks_ = 0; ks_ < 4; ++ks_) qf[p_][ks_] = *(const bf16x8*)(qp_ + p_ * 128 + ks_ * 32); } while (0)
    int su = F.vcu;
    if (su < NSU) P10_LOADQ(su, 0);
#pragma unroll 1
    for (; su < NSU; su += F.G) {
        const int h = su & 7, t0 = (su >> 3) * 256;
        if (h != cur_h) {
            __syncthreads();
            for (int q = tid; q < 4096; q += NTHREADS) { const int row = q >> 4, cc = q & 15; *(LAS u32x4*)(KS + row * 136 + cc * 8) = *(const u32x4*)(KEYS + (size_t)h * 32768 + row * 128 + cc * 8); }
            cur_h = h;
            __syncthreads();
        }
#pragma unroll 1
        for (int j = 0; j < 2; ++j) {
            const int tb = t0 + (2 * w + j) * 16;
            f32x2v V0[16], V1[16];
            {
                f32x4 acc[2][8];
#pragma unroll
                for (int p = 0; p < 2; ++p)
#pragma unroll
                    for (int kt = 0; kt < 8; ++kt) acc[p][kt] = (f32x4){0.f, 0.f, 0.f, 0.f};
#pragma unroll
                for (int p = 0; p < 2; ++p)
#pragma unroll
                    for (int ks = 0; ks < 4; ++ks)
#pragma unroll
                        for (int kt = 0; kt < 8; ++kt) acc[p][kt] = mfma16(ldfrag(KS, 136, p * 128 + kt * 16, ks * 32, lane), qf[p][ks], acc[p][kt]);
#pragma unroll
                for (int kt = 0; kt < 8; ++kt)
#pragma unroll
                    for (int hh = 0; hh < 2; ++hh) { const float a0 = acc[0][kt][2 * hh], a1 = acc[0][kt][2 * hh + 1], b0 = acc[1][kt][2 * hh], b1 = acc[1][kt][2 * hh + 1];
                        V0[2 * kt + hh] = (f32x2v){fabsf(a0) < 0x1p-60f ? 0.f : a0, fabsf(a1) < 0x1p-60f ? 0.f : a1};
                        V1[2 * kt + hh] = (f32x2v){fabsf(b0) < 0x1p-60f ? 0.f : b0, fabsf(b1) < 0x1p-60f ? 0.f : b1}; __builtin_amdgcn_sched_barrier(0); }
            }
            {
                const int nsu = (j == 0) ? su : su + F.G;
                if (nsu < NSU) P10_LOADQ(nsu, j ^ 1);
            }
            float gmx0, gmx1, lo0, lo1, hi0, hi1, n0 = 0.f, n1 = 0.f;
            { float mx0 = V0[0][0], mn0 = V0[0][0], mx1 = V1[0][0], mn1 = V1[0][0];
#pragma unroll
              for (int i = 0; i < 16; ++i)
#pragma unroll
                  for (int e = 0; e < 2; ++e) { mx0 = fmaxf(mx0, V0[i][e]); mn0 = fminf(mn0, V0[i][e]); mx1 = fmaxf(mx1, V1[i][e]); mn1 = fminf(mn1, V1[i][e]); }
              gmx0 = q4max(mx0); gmx1 = q4max(mx1); lo0 = q4min(mn0) - 1.0f; lo1 = q4min(mn1) - 1.0f; hi0 = gmx0; hi1 = gmx1; }
            for (int it = 0; it < 48; ++it) {
                const float m0 = 0.5f * (lo0 + hi0), m1 = 0.5f * (lo1 + hi1);
                n0 = p10_count<16>(V0, m0); n1 = p10_count<16>(V1, m1);
                const float c0 = q4sum(n0), c1 = q4sum(n1);
                lo0 = (c0 >= 16.f) ? m0 : lo0; hi0 = (c0 <= 16.f) ? m0 : hi0; lo1 = (c1 >= 16.f) ? m1 : lo1; hi1 = (c1 <= 16.f) ? m1 : hi1;
                if (__all(lo0 == hi0 && lo1 == hi1)) break;
            }
            const unsigned lb0 = (unsigned)((tok * 2 + 0) * 64), lb1 = (unsigned)((tok * 2 + 1) * 64), dump1 = 2048u + 4u * (unsigned)lane;
            if (__all(lo0 == hi0 && lo1 == hi1)) {
                const int pre = q4prefix((int)n0 | ((int)n1 << 8), g);
                p10_emit_fast<16, 1>(V0, hi0, lb0 + 4u * (unsigned)(pre & 255), dump1, LVb, LIb, 4 * g);
                p10_emit_fast<16, 1>(V1, hi1, lb1 + 4u * (unsigned)(pre >> 8), dump1, LVb, LIb, 4 * g);
            } else {
                p10_emit_general<16, 1>(V0, lo0, hi0, g, lb0, dump1, LVb, LIb, 4 * g);
                p10_emit_general<16, 1>(V1, lo1, hi1, g, lb1, dump1, LVb, LIb, 4 * g);
            }
            LDS_WAIT();
            f32x2v CS[32];
            { const f32x4 v1 = *(const LAS f32x4*)(LVb + lb0 + 16 * g);
#pragma unroll
              for (int k = 0; k < 4; ++k) { const f32x4 v2 = *(const LAS f32x4*)(LVb + lb1 + 16 * k);
#pragma unroll
                  for (int a = 0; a < 4; ++a) { CS[8 * a + 2 * k] = (f32x2v){v1[a] + v2[0], v1[a] + v2[1]}; CS[8 * a + 2 * k + 1] = (f32x2v){v1[a] + v2[2], v1[a] + v2[3]}; } } }
            const float m2 = fmaxf(gmx0 + lo1, gmx1 + lo0);
            float lo2 = (lo0 == hi0 && lo1 == hi1) ? m2 - fmaxf(fabsf(m2) * 1e-6f, 1e-30f) : lo0 + lo1 - 1.0f, hi2 = gmx0 + gmx1, n2 = 0.f;
            for (int it = 0; it < 48; ++it) {
                const float m2 = 0.5f * (lo2 + hi2);
                n2 = p10_count<32>(CS, m2);
                const float c2 = q4sum(n2);
                lo2 = (c2 >= 16.f) ? m2 : lo2; hi2 = (c2 <= 16.f) ? m2 : hi2;
                if (__all(lo2 == hi2)) break;
            }
            const unsigned ob = (unsigned)(tok * 64), dump2 = 1024u + 4u * (unsigned)lane;
            if (__all(lo2 == hi2)) p10_emit_fast<32, 2>(CS, hi2, ob + 4u * (unsigned)q4prefix((int)n2, g), dump2, OVb, OCb, 64 * g);
            else p10_emit_general<32, 2>(CS, lo2, hi2, g, ob, dump2, OVb, OCb, 64 * g);
            LDS_WAIT();
#pragma unroll
            for (int ps = 0; ps < 4; ++ps) { const int tk = 4 * ps + g, q = tok;
                const float vv = *(const LAS float*)(OVb + tk * 64 + q * 4); const int code = *(const LAS int*)(OCb + tk * 64 + q * 4);
                const int i1 = *(const LAS int*)(LIb + (tk * 2) * 64 + (code >> 4) * 4), i2 = *(const LAS int*)(LIb + (tk * 2 + 1) * 64 + (code & 15) * 4);
                const float m = gmax16(vv); const float e = __expf(vv - m); const float sum = gsumf16(e);
                const size_t o = (size_t)(tb + tk) * 128 + h * 16 + q; IDX[o] = i1 * 128 + i2; GATEW[o] = e * __builtin_amdgcn_rcpf(sum); }
            LDS_WAIT();
        }
    }
#undef P10_LOADQ
}

constexpr size_t WS_PD = WS_PROJ, WS_COEF = WS_PROJ + 320 * MiB, WS_SSQ2 = WS_PROJ + 352 * MiB;
__device__ __forceinline__ void fp8x16_to_f32(const u32x4 r, float* f) {
    const unsigned w[4] = {r.x, r.y, r.z, r.w};
#pragma unroll
    for (int i = 0; i < 4; ++i) { const f32x2v a = __builtin_amdgcn_cvt_pk_f32_fp8((int)w[i], false), bq = __builtin_amdgcn_cvt_pk_f32_fp8((int)w[i], true); f[4 * i] = a[0]; f[4 * i + 1] = a[1]; f[4 * i + 2] = bq[0]; f[4 * i + 3] = bq[1]; }
}
__device__ __forceinline__ float gelu_erf(float v) {
    const float av = fabsf(v), t = __builtin_amdgcn_rcpf(av * 0.2316418882f + 1.0f);
    float q = t * 0.5307027145f + (-0.7265760135f); q = q * t + 0.7107068705f; q = q * t + (-0.142248368f); q = q * t + 0.127414796f; q = q * t;
    const float e = __builtin_amdgcn_exp2f((v * v) * (-0.72134752044f));
    const float m = v * (q * e);
    return v < 0.f ? m : v - m;
}
__device__ __forceinline__ void fp8x16_to_f32x2(const u32x4 r, f32x2v* f2) {
    const unsigned w[4] = {r.x, r.y, r.z, r.w};
#pragma unroll
    for (int i = 0; i < 4; ++i) { f2[2 * i] = __builtin_amdgcn_cvt_pk_f32_fp8((int)w[i], false); f2[2 * i + 1] = __builtin_amdgcn_cvt_pk_f32_fp8((int)w[i], true); }
}
__device__ __forceinline__ float gsumf8(float s) { s += dpp_f<0xB1>(s); s += dpp_f<0x4E>(s); s += dpp_f<0x141>(s); return s; }
__device__ __forceinline__ int ld_i32(const void* base, unsigned boff) { return *(const int*)((const char*)base + boff); }
__device__ __forceinline__ float ld_f32(const void* base, unsigned boff) { return *(const float*)((const char*)base + boff); }
__device__ __forceinline__ u32x4 ld_u32x4(const void* base, unsigned boff) { return *(const u32x4*)((const char*)base + boff); }
typedef _Float16 h2v __attribute__((ext_vector_type(2)));
template <int MODE> __device__ __forceinline__ void p11a_down(Frame& F) {
    F.fresh();
    const bf16_t* HB = (const bf16_t*)(F.ws + WS_WBUF); const int* IDX = (const int*)(F.ws + WS_IDX); const unsigned char* ED = (const unsigned char*)(F.ws + WS_EDOWN); bf16_t* PD = (bf16_t*)(F.ws + WS_PD);
    const int lane = F.lane, w = F.wave, r = lane >> 3, c = lane & 7;
    const int bps = F.sl_n, s = F.sl_s, rk = F.sl_rk;
    const int tpw = NTOK / (bps * NWAVES);
    const size_t tbeg = ((size_t)rk * NWAVES + w) * tpw;
    const unsigned char* EDb = ED + (size_t)s * (16384 * 128);
    const unsigned coff = 16u * (unsigned)c;
    u32x4 q0[8], q1[8], q2[8], q3[8]; int enA[16], enB[16];
    LAS unsigned char* ST = F.lds + w * 4096;
    u32x4 sti[2];
    const int nblk = tpw / 4;
#define P11A_BLK_LOAD(bb) do { const size_t tb_ = tbeg + (size_t)(bb) * 4; _Pragma("unroll") for (int j = 0; j < 2; ++j) sti[j] = *(const u32x4*)((const unsigned char*)IDX + tb_ * 512 + 1024 * j + 16 * lane); } while (0)
#define P11A_BLK_STORE(bb) do { LAS unsigned char* d_ = ST + ((bb) & 1) * 2048; _Pragma("unroll") for (int j = 0; j < 2; ++j) *(LAS u32x4*)(d_ + 1024 * j + 16 * lane) = sti[j]; } while (0)
#define P11A_IDS(en, tt) do { const int tj_ = (int)((tt) - tbeg); const LAS unsigned char* tp_ = ST + ((tj_ >> 2) & 1) * 2048 + (tj_ & 3) * 512 + 64 * r; \
        _Pragma("unroll") for (int q = 0; q < 4; ++q) { const u32x4 e4_ = *(const LAS u32x4*)(tp_ + 16 * q); en[4 * q] = (int)e4_.x; en[4 * q + 1] = (int)e4_.y; en[4 * q + 2] = (int)e4_.z; en[4 * q + 3] = (int)e4_.w; } } while (0)
#define P11A_LOAD(buf, en, h8) do { _Pragma("unroll") for (int i = 0; i < 8; ++i) buf[i] = ld_u32x4(EDb, (MODE == 2 ? ((unsigned)en[(h8) + i] & 1u) : (unsigned)en[(h8) + i]) * 128u + coff); } while (0)
#define P11A_DOTS(buf, koff) do { if (MODE == 1) { unsigned x_ = 0; _Pragma("unroll") for (int i = 0; i < 8; ++i) x_ ^= buf[i].x ^ buf[i].y ^ buf[i].z ^ buf[i].w; if (c == 0) pd[(koff)] = (bf16_t)(x_ & 0xffffu); } \
        else { float p_[8]; \
              \
            _Pragma("unroll") for (int i = 0; i < 8; ++i) { const unsigned w_[4] = {buf[i].x, buf[i].y, buf[i].z, buf[i].w}; float d0 = 0.f, d1 = 0.f; \
                _Pragma("unroll") for (int j = 0; j < 4; ++j) { d0 = __builtin_amdgcn_fdot2(__builtin_amdgcn_cvt_scalef32_pk_f16_fp8(w_[j], 1.0f, false), hv[2 * j], d0, false); \
                    d1 = __builtin_amdgcn_fdot2(__builtin_amdgcn_cvt_scalef32_pk_f16_fp8(w_[j], 1.0f, true), hv[2 * j + 1], d1, false); } \
                p_[i] = d0 + d1; } \
              \
            float q4_[4], q2_[2]; \
            _Pragma("unroll") for (int k = 0; k < 4; ++k) { const float keep = cb0 ? p_[4 + k] : p_[k], send = cb0 ? p_[k] : p_[4 + k]; q4_[k] = keep + dpp_f<0xB1>(send); } \
            _Pragma("unroll") for (int k = 0; k < 2; ++k) { const float keep = cb1 ? q4_[2 + k] : q4_[k], send = cb1 ? q4_[k] : q4_[2 + k]; q2_[k] = keep + dpp_f<0x4E>(send); } \
            { const float keep = cb2 ? q2_[1] : q2_[0], send = cb2 ? q2_[0] : q2_[1]; \
              pd[(koff) + crow] = f2bf(keep + xlane4(send)); } } } while (0)
#define P11A_HV(tt) do { float a[8], bq[8]; unpack8(*(const u32x4*)(HBs + (tt) * DM), a); unpack8(*(const u32x4*)(HBs + (tt) * DM + 8), bq); \
        _Pragma("unroll") for (int i = 0; i < 4; ++i) { hv[i] = (h2v){(_Float16)a[2 * i], (_Float16)a[2 * i + 1]}; hv[4 + i] = (h2v){(_Float16)bq[2 * i], (_Float16)bq[2 * i + 1]}; } } while (0)
    const bf16_t* HBs = HB + 128 * s + 16 * c;
    const bool cb0 = c & 1, cb1 = c & 2, cb2 = c & 4; const int crow = ((c & 1) << 2) | (c & 2) | ((c & 4) >> 2);
    const size_t tlast = tbeg + tpw - 1;
#define P11A_CLAMP(x) (((x) <= tlast) ? (x) : tlast)
    P11A_BLK_LOAD(0); P11A_BLK_STORE(0);
    if (nblk > 1) P11A_BLK_LOAD(1);
    LDS_WAIT();
    P11A_IDS(enA, tbeg); P11A_IDS(enB, tbeg + 1);
    P11A_LOAD(q0, enA, 0); P11A_LOAD(q1, enA, 8); P11A_LOAD(q2, enB, 0); P11A_LOAD(q3, enB, 8);
    P11A_IDS(enA, P11A_CLAMP(tbeg + 2)); P11A_IDS(enB, P11A_CLAMP(tbeg + 3));
#pragma unroll 1
    for (int ti = 0; ti < tpw; ti += 2) {
        const size_t t = tbeg + ti;
        if ((ti & 3) == 0) { const int bb = ti >> 2; if (bb + 1 < nblk) P11A_BLK_STORE(bb + 1); if (bb + 2 < nblk) P11A_BLK_LOAD(bb + 2); }
        h2v hv[8];
        { P11A_HV(t); bf16_t* pd = PD + ((size_t)s * NTOK + t) * 128 + 16 * r;
          P11A_DOTS(q0, 0); P11A_LOAD(q0, enA, 0);
          P11A_DOTS(q1, 8); P11A_LOAD(q1, enA, 8); }
        P11A_IDS(enA, P11A_CLAMP(t + 4));
        { P11A_HV(t + 1); bf16_t* pd = PD + ((size_t)s * NTOK + t + 1) * 128 + 16 * r;
          P11A_DOTS(q2, 0); P11A_LOAD(q2, enB, 0);
          P11A_DOTS(q3, 8); P11A_LOAD(q3, enB, 8); }
        P11A_IDS(enB, P11A_CLAMP(t + 5));
    }
#undef P11A_IDS
#undef P11A_BLK_LOAD
#undef P11A_BLK_STORE
#undef P11A_LOAD
#undef P11A_DOTS
#undef P11A_HV
#undef P11A_CLAMP
}
__device__ __forceinline__ void p11b_coef(Frame& F) {
    F.fresh();
    const bf16_t* PD = (const bf16_t*)(F.ws + WS_PD); const float* SSQ = (const float*)(F.ws + WS_SSQ); const float* GATEW = (const float*)(F.ws + WS_GATEW); float* CF = (float*)(F.ws + WS_COEF);
    const size_t gt = (size_t)F.vcu * NTHREADS + F.tid, NGT = (size_t)F.G * NTHREADS;
    for (size_t i = gt; i < (size_t)NTOK * 16; i += NGT) {
        const size_t t = i >> 4; const int k8 = (int)(i & 15) * 8;
        float acc[8];
        unpack8(*(const u32x4*)(PD + t * 128 + k8), acc);
#pragma unroll
        for (int s = 1; s < 8; ++s) { float p[8]; unpack8(*(const u32x4*)(PD + ((size_t)s * NTOK + t) * 128 + k8), p);
#pragma unroll
            for (int e = 0; e < 8; ++e) acc[e] += p[e]; }
        const f32x4* sp = (const f32x4*)(SSQ + t * 16); const f32x4 s4 = (sp[0] + sp[1]) + (sp[2] + sp[3]);
        const float rs = (1.0f / ED_SCALE) * __builtin_amdgcn_rsqf(((s4[0] + s4[1]) + (s4[2] + s4[3])) * (1.f / DM) + EPS);
        const f32x4 g0 = *(const f32x4*)(GATEW + t * 128 + k8), g1 = *(const f32x4*)(GATEW + t * 128 + k8 + 4);
        f32x4 o0, o1;
#pragma unroll
        for (int e = 0; e < 4; ++e) { o0[e] = gelu_erf(acc[e] * rs) * g0[e] * (1.0f / EU_SCALE); o1[e] = gelu_erf(acc[4 + e] * rs) * g1[e] * (1.0f / EU_SCALE); }
        *(f32x4*)(CF + t * 128 + k8) = o0; *(f32x4*)(CF + t * 128 + k8 + 4) = o1;
    }
}
__device__ __forceinline__ void p11c_up(Frame& F) {
    F.fresh();
    const int* IDX = (const int*)(F.ws + WS_IDX); const unsigned char* EU = (const unsigned char*)(F.ws + WS_EUP); const float* CF = (const float*)(F.ws + WS_COEF); float* SSQ2 = (float*)(F.ws + WS_SSQ2); bf16_t* HBr = (bf16_t*)(F.ws + WS_WBUF);
    const int lane = F.lane, w = F.wave, r = lane >> 3, c = lane & 7;
    const int bps = F.sl_n, s = F.sl_s, rk = F.sl_rk;
    const int tpw = NTOK / (bps * NWAVES);
    const size_t tbeg = ((size_t)rk * NWAVES + w) * tpw;
    const unsigned char* EUb = EU + (size_t)s * (16384 * 128);
    const unsigned coff = 16u * (unsigned)c;
    const int r0 = r & 1, r1 = (r >> 1) & 1, r2 = (r >> 2) & 1;
    const int eoff = 8 * r0 + 4 * r1 + 2 * r2;
    LAS unsigned char* ST = F.lds + w * 16384;
    u32x4 sti[4], stc[4];
#define P11C_BLK_LOAD(bb) do { const size_t tb_ = tbeg + (size_t)(bb) * 8; _Pragma("unroll") for (int j = 0; j < 4; ++j) { \
            sti[j] = *(const u32x4*)((const unsigned char*)IDX + tb_ * 512 + 1024 * j + 16 * lane); stc[j] = *(const u32x4*)((const unsigned char*)CF + tb_ * 512 + 1024 * j + 16 * lane); } } while (0)
#define P11C_BLK_STORE(bb) do { LAS unsigned char* d_ = ST + ((bb) & 1) * 8192; _Pragma("unroll") for (int j = 0; j < 4; ++j) { \
            *(LAS u32x4*)(d_ + 1024 * j + 16 * lane) = sti[j]; *(LAS u32x4*)(d_ + 4096 + 1024 * j + 16 * lane) = stc[j]; } } while (0)
#define P11C_TOKP(tj) (ST + (((tj) >> 3) & 1) * 8192 + ((tj) & 7) * 512 + 64 * r)
    const int nblk = tpw / 8;
    P11C_BLK_LOAD(0); P11C_BLK_STORE(0);
    if (nblk > 1) P11C_BLK_LOAD(1);
    LDS_WAIT();
    u32x4 a0[8], a1[8], b0[8], b1[8];
#define P11C_LOADQ(buf, tj, hf, q) do { const u32x4 e4 = *(const LAS u32x4*)(P11C_TOKP(tj) + 32 * (hf) + 16 * (q)); \
            buf[4 * (q)] = ld_u32x4(EUb, e4.x * 128u + coff); buf[4 * (q) + 1] = ld_u32x4(EUb, e4.y * 128u + coff); buf[4 * (q) + 2] = ld_u32x4(EUb, e4.z * 128u + coff); buf[4 * (q) + 3] = ld_u32x4(EUb, e4.w * 128u + coff); } while (0)
#define P11C_LOADHALF(buf, tj, hf) do { P11C_LOADQ(buf, tj, hf, 0); P11C_LOADQ(buf, tj, hf, 1); } while (0)
#define P11C_ACCQ(buf, tj, hf, q) do { const f32x4 c0_ = *(const LAS f32x4*)(P11C_TOKP(tj) + 4096 + 32 * (hf) + 16 * (q)); \
        _Pragma("unroll") for (int i = 0; i < 4; ++i) { f32x2v f2[8]; fp8x16_to_f32x2(buf[4 * (q) + i], f2); const f32x2v cc2 = {c0_[i], c0_[i]}; \
            _Pragma("unroll") for (int k = 0; k < 8; ++k) y2[k] = __builtin_elementwise_fma(cc2, f2[k], y2[k]); } } while (0)
#define P11C_STEP(buf, tj, tn, hf) do { P11C_ACCQ(buf, tj, hf, 0); P11C_LOADQ(buf, tn, hf, 0); P11C_ACCQ(buf, tj, hf, 1); P11C_LOADQ(buf, tn, hf, 1); } while (0)
#define P11C_FINISH(tt) do { float y[16]; _Pragma("unroll") for (int k = 0; k < 8; ++k) { y[2 * k] = y2[k][0]; y[2 * k + 1] = y2[k][1]; } \
        float y8[8], y4[4], yf[2]; \
        _Pragma("unroll") for (int k = 0; k < 8; ++k) { const float keep = r0 ? y[8 + k] : y[k], send = r0 ? y[k] : y[8 + k]; y8[k] = keep + xlane8(send); } \
        _Pragma("unroll") for (int k = 0; k < 4; ++k) { const float keep = r1 ? y8[4 + k] : y8[k], send = r1 ? y8[k] : y8[4 + k]; y4[k] = keep + xlane16(send, (lane >> 4) & 1); } \
        _Pragma("unroll") for (int k = 0; k < 2; ++k) { const float keep = r2 ? y4[2 + k] : y4[k], send = r2 ? y4[k] : y4[2 + k]; yf[k] = keep + xlane32(send, lane >= 32); } \
        const float z0 = hh[0] + yf[0], z1 = hh[1] + yf[1]; \
        const unsigned zw = pg8::cvt_pk_bf16(z0, z1); *hrow = zw; \
        const float zr0 = bflo(zw), zr1 = bfhi(zw); \
        const float ss = wave_sum_dpp(zr0 * zr0 + zr1 * zr1); \
        if (lane == 0) SSQ2[(tt) * 8 + s] = ss; } while (0)
#define P11C_CLAMPI(x) (((x) < tpw) ? (x) : tpw - 1)
    P11C_LOADHALF(a0, 0, 0); P11C_LOADHALF(a1, 0, 1); P11C_LOADHALF(b0, P11C_CLAMPI(1), 0); P11C_LOADHALF(b1, P11C_CLAMPI(1), 1);
#pragma unroll 1
    for (int ti = 0; ti < tpw; ti += 2) {
        const size_t t = tbeg + ti;
        if ((ti & 7) == 0) {
            const int bb = ti >> 3;
            if (bb + 1 < nblk) P11C_BLK_STORE(bb + 1);
            if (bb + 2 < nblk) P11C_BLK_LOAD(bb + 2);
        }
        {
            unsigned* hrow = (unsigned*)(HBr + t * DM + 128 * s + 16 * c + eoff);
            const unsigned hbw = *hrow; const f32x2v hh = {bflo(hbw), bfhi(hbw)};
            f32x2v y2[8];
#pragma unroll
            for (int k = 0; k < 8; ++k) y2[k] = (f32x2v){0.f, 0.f};
            { const int tn_ = P11C_CLAMPI(ti + 2); P11C_STEP(a0, ti, tn_, 0); P11C_STEP(a1, ti, tn_, 1); }
            P11C_FINISH(t);
        }
        if (ti + 1 < tpw) {
            unsigned* hrow = (unsigned*)(HBr + (t + 1) * DM + 128 * s + 16 * c + eoff);
            const unsigned hbw = *hrow; const f32x2v hh = {bflo(hbw), bfhi(hbw)};
            f32x2v y2[8];
#pragma unroll
            for (int k = 0; k < 8; ++k) y2[k] = (f32x2v){0.f, 0.f};
            { const int tn_ = P11C_CLAMPI(ti + 3); P11C_STEP(b0, ti + 1, tn_, 0); P11C_STEP(b1, ti + 1, tn_, 1); }
            P11C_FINISH(t + 1);
        }
    }
#undef P11C_LOADHALF
#undef P11C_LOADQ
#undef P11C_ACCQ
#undef P11C_STEP
#undef P11C_FINISH
#undef P11C_CLAMPI
#undef P11C_BLK_LOAD
#undef P11C_BLK_STORE
#undef P11C_TOKP
}
__device__ __forceinline__ void p11d_final(Frame& F) {
    F.fresh();
    const float* SSQ2 = (const float*)(F.ws + WS_SSQ2); const bf16_t* Z = (const bf16_t*)(F.ws + WS_WBUF);
    const int gw = F.vcu * NWAVES + F.wave, NGW = F.G * NWAVES, lane = F.lane;
    f32x4 fw[4];
#pragma unroll
    for (int q = 0; q < 4; ++q) fw[q] = *(const f32x4*)(F.final_norm_w + (q >> 1) * 512 + lane * 8 + (q & 1) * 4);
    u32x4 zn[2]; f32x4 sn[2];
    if (gw < NTOK) { const f32x4* sp = (const f32x4*)(SSQ2 + (size_t)gw * 8); sn[0] = sp[0]; sn[1] = sp[1];
        const bf16_t* zrow = Z + (size_t)gw * DM; zn[0] = *(const u32x4*)(zrow + lane * 8); zn[1] = *(const u32x4*)(zrow + 512 + lane * 8); }
#pragma unroll 1
    for (int t = gw; t < NTOK; t += NGW) {
        const u32x4 zc0 = zn[0], zc1 = zn[1]; const f32x4 s4 = sn[0] + sn[1];
        { const int tn = (t + NGW < NTOK) ? t + NGW : t; const f32x4* sp = (const f32x4*)(SSQ2 + (size_t)tn * 8); sn[0] = sp[0]; sn[1] = sp[1];
          const bf16_t* zrow = Z + (size_t)tn * DM; zn[0] = *(const u32x4*)(zrow + lane * 8); zn[1] = *(const u32x4*)(zrow + 512 + lane * 8); }
        const float r2 = 1.0f / sqrtf(((s4[0] + s4[1]) + (s4[2] + s4[3])) * (1.f / DM) + EPS);
        float* row = F.out + (size_t)t * DM;
#pragma unroll
        for (int q = 0; q < 2; ++q) { float z[8]; unpack8(q ? zc1 : zc0, z);
            const f32x4 z0 = {z[0], z[1], z[2], z[3]}, z1 = {z[4], z[5], z[6], z[7]};
            *(f32x4*)(row + q * 512 + lane * 8) = z0 * r2 * fw[2 * q]; *(f32x4*)(row + q * 512 + lane * 8 + 4) = z1 * r2 * fw[2 * q + 1]; }
    }
}

#define XB_TMO      128
#define XB_XCNT(j)  (256  + 64 * (j))
#define XB_XSUB(j)  (1280 + 64 * (j))
#define XB_XGEN(j)  (2304 + 64 * (j))
#define XB_TOP      3328
#define XB_TOPGEN   3392
#define XCD_BAR_WORDS 3456
#define XB_SPIN_CAP (1u << 18)

__device__ __forceinline__ unsigned xb_ld(unsigned* p)              { return __hip_atomic_load(p, __ATOMIC_RELAXED, __HIP_MEMORY_SCOPE_AGENT); }
__device__ __forceinline__ unsigned xb_add(unsigned* p, unsigned v) { return __hip_atomic_fetch_add(p, v, __ATOMIC_RELAXED, __HIP_MEMORY_SCOPE_AGENT); }
__device__ __forceinline__ unsigned xb_xcc_id() { return (unsigned)__builtin_amdgcn_s_getreg((3 << 11) | 20) & 0xFu; }
#define XB_SPIN(cond, bar) do { unsigned _sp = 0; while (cond) { __builtin_amdgcn_s_sleep(1); \
    if ((++_sp & 255u) == 0u) { if (xb_ld(&(bar)[XB_TMO])) break; if (_sp > XB_SPIN_CAP) { atomicAdd(&(bar)[XB_TMO], 1u); break; } } } } while (0)

struct XcdBarrier {
    unsigned* bar; unsigned x;
    volatile LAS unsigned* st;
};

__device__ __forceinline__ XcdBarrier xcd_barrier_post(unsigned* bar, volatile LAS unsigned* st) {
    XcdBarrier b; b.bar = bar; b.x = xb_xcc_id(); b.st = st;
    if (threadIdx.x == 0) (void)xb_add(&bar[XB_XCNT(b.x)], 1u);
    return b;
}
__device__ __forceinline__ void xcd_barrier_complete(unsigned* bar, unsigned x, unsigned& nloc, unsigned& nx) {
    const unsigned G = gridDim.x * gridDim.y * gridDim.z;
    unsigned sum, cnt, mine, sp = 0u;
    for (;;) {
        sum = 0u; cnt = 0u; mine = 0u;
#pragma unroll
        for (unsigned j = 0; j < 16; ++j) { const unsigned c = xb_ld(&bar[XB_XCNT(j)]); sum += c; cnt += (c > 0u) ? 1u : 0u; mine = (j == x) ? c : mine; }
        if (sum == G) break;
        __builtin_amdgcn_s_sleep(1);
        if ((++sp & 255u) == 0u) { if (xb_ld(&bar[XB_TMO])) break; if (sp > XB_SPIN_CAP) { atomicAdd(&bar[XB_TMO], 1u); break; } }
    }
    nloc = mine > 0u ? mine : 1u; nx = cnt > 0u ? cnt : 1u;
}

__device__ __forceinline__ void xcd_barrier(const XcdBarrier& b) {
    asm volatile("s_waitcnt vmcnt(0)" ::: "memory");
    __syncthreads();
    if (threadIdx.x == 0) {
        unsigned* bar = b.bar;
        __builtin_amdgcn_s_waitcnt(0);
        unsigned nloc = b.st[0], nx = b.st[1];
        if (nloc == 0u) { xcd_barrier_complete(bar, b.x, nloc, nx); b.st[0] = nloc; b.st[1] = nx; }
        const unsigned old = xb_add(&bar[XB_XSUB(b.x)], 1u);
        const unsigned gen = old / nloc;
        if (old + 1u == (gen + 1u) * nloc) {
            __builtin_amdgcn_fence(__ATOMIC_RELEASE, "agent");
            asm volatile("s_waitcnt vmcnt(0)" ::: "memory");
            const unsigned og = xb_add(&bar[XB_TOP], 1u);
            const unsigned tg = og / nx;
            if (og + 1u == (tg + 1u) * nx) xb_add(&bar[XB_TOPGEN], 1u);
            else XB_SPIN(xb_ld(&bar[XB_TOPGEN]) == tg, bar);
            __builtin_amdgcn_fence(__ATOMIC_ACQUIRE, "agent");
            xb_add(&bar[XB_XGEN(b.x)], 1u);
            asm volatile("s_waitcnt vmcnt(0)" ::: "memory");
        } else {
            XB_SPIN(xb_ld(&bar[XB_XGEN(b.x)]) == gen, bar);
            __builtin_amdgcn_fence(__ATOMIC_ACQUIRE, "agent");
            asm volatile("s_waitcnt vmcnt(0)" ::: "memory");
        }
    }
    __syncthreads();
}
#ifdef USE_CG
static __device__ __forceinline__ void grid_barrier(cg::grid_group& grid) {
    asm volatile("s_waitcnt vmcnt(0) lgkmcnt(0)" ::: "memory");
    __syncthreads();
    if (threadIdx.x == 0) { __builtin_amdgcn_fence(__ATOMIC_RELEASE, "agent"); asm volatile("s_waitcnt vmcnt(0)" ::: "memory"); }
    grid.sync();
    if (threadIdx.x == 0) { __builtin_amdgcn_fence(__ATOMIC_ACQUIRE, "agent"); asm volatile("s_waitcnt vmcnt(0)" ::: "memory"); }
    __syncthreads();
}
#define GRID_BARRIER() grid_barrier(grid)
#else
#define GRID_BARRIER() xcd_barrier(xbar)
#endif

#ifdef DUMP_AFTER
static __device__ __forceinline__ void dbg_dump(Frame& F, int mode) {
    const size_t gt = (size_t)F.vcu * NTHREADS + F.tid, NGT = (size_t)F.G * NTHREADS;
    const bf16_t* PROJ = (const bf16_t*)(F.ws + WS_PROJ); const bf16_t* WBUF = (const bf16_t*)(F.ws + WS_WBUF); const bf16_t* ABUF = (const bf16_t*)(F.ws + WS_ABUF);
    const bf16_t* POOLED = (const bf16_t*)(F.ws + WS_POOLED); const float* GC = (const float*)(F.ws + WS_GC); const bf16_t* Q2 = (const bf16_t*)(F.ws + WS_Q2);
    const int* IDX = (const int*)(F.ws + WS_IDX); const float* GATEW = (const float*)(F.ws + WS_GATEW);
    for (size_t i = gt; i < (size_t)NTOK * DM; i += NGT) {
        const size_t t = i >> 10; const int cidx = (int)(i & 1023);
        float v = 0.f;
        if (mode == 1 || mode == 3) { const bf16_t* r = PROJ + t * P1N; v = bf2f(r[cidx]) + bf2f(r[1024 + cidx]) + bf2f(r[2048 + cidx]) + bf2f(r[3072 + cidx]) + bf2f(r[3584 + cidx]); }
        if (mode == 2) v = bf2f(POOLED[t * 512 + (cidx & 511)]);
        if (mode == 3) v += bf2f(WBUF[t * DM + cidx]) + bf2f(ABUF[(t >> 6) * 8 * 4096 + (size_t)(cidx >> 7) * 4096 + (t & 63) * 64 + (cidx & 63)]) + GC[t * 8 + (cidx & 7)];
        if (mode == 4 || mode == 5) v = bf2f(PROJ[t * P1N + C_V + cidx]);
        if (mode == 6 || mode == 7) v = bf2f(ABUF[t * DM + cidx]);
        if (mode == 9) v = bf2f(Q2[t * 2048 + cidx]) + bf2f(Q2[t * 2048 + 1024 + cidx]);
        if (mode == 10) v = (float)IDX[t * 128 + (cidx & 127)] * 1e-3f + GATEW[t * 128 + (cidx & 127)];
        F.out[i] = v;
    }
}
#define DUMP(k) do { if (DUMP_AFTER == (k)) { if ((k) != 8) dbg_dump(F, (k)); return; } } while (0)
#else
#define DUMP(k) do {} while (0)
#endif

#ifdef TIMING_A
#define TS_OFF (LDS_BYTES - 256)
#define STAMP(k) do { if (blockIdx.x == 0 && threadIdx.x == 0) ((volatile LAS unsigned long long*)(F.lds + TS_OFF))[(k)] = __builtin_amdgcn_s_memrealtime(); } while (0)
#else
#define STAMP(k) do {} while (0)
#endif
#ifndef PHM
#define PHM 0x1fff
#endif
__global__ void __launch_bounds__(NTHREADS, 2) hybrid_fwd(Params p) {
    extern __shared__ __attribute__((aligned(16))) unsigned char lds_raw[];
#ifdef USE_CG
    cg::grid_group grid = cg::this_grid();
#endif
    Frame F;
    F.lds = (LAS unsigned char*)lds_raw;
    F.tid = threadIdx.x; F.lane = F.tid & 63; F.wave = __builtin_amdgcn_readfirstlane(F.tid >> 6);
    F.G = gridDim.x; { const int bx = blockIdx.x; F.vcu = (F.G % 8 == 0) ? (bx % 8) * (F.G / 8) + bx / 8 : bx; }
    F.x = p.in[0]; F.mix_norm_w = p.in[1]; F.w_in = p.in[2]; F.pool_w = p.in[3]; F.pool_scale = p.in[4]; F.conv_w = p.in[5]; F.a_log = p.in[6]; F.dt_bias = p.in[7]; F.dn_norm_w = p.in[8];
    F.w_pool_up = p.in[9]; F.w_dn_up = p.in[10]; F.w_mix_out = p.in[11]; F.ffn_norm_w = p.in[12]; F.w_query = p.in[13]; F.keys1 = p.in[14]; F.keys2 = p.in[15]; F.peer_down = p.in[16]; F.peer_up = p.in[17]; F.final_norm_w = p.in[18];
    F.out = p.out; F.ws = p.ws;
    unsigned char* ws = p.ws;
#ifndef USE_CG
    {
        volatile LAS unsigned* st = (volatile LAS unsigned*)(F.lds + XB_ST_OFF);
        if (threadIdx.x < 2) st[threadIdx.x] = 0u;
        __syncthreads();
    }
    const XcdBarrier xbar = xcd_barrier_post((unsigned*)ws, (volatile LAS unsigned*)(F.lds + XB_ST_OFF));
#endif
#ifndef USE_CG
    int xticket = 0;
    if (threadIdx.x == 0) xticket = (int)xb_add((unsigned*)ws + 3584 + 64 * xbar.x, 1u);
#endif
    bf16_t* XN = (bf16_t*)p.out; bf16_t* GB = (bf16_t*)((unsigned char*)p.out + 128 * MiB);
    bf16_t* PROJ = (bf16_t*)(ws + WS_PROJ); bf16_t* WIN = (bf16_t*)(ws + WS_WIN);
    bf16_t* GA = (bf16_t*)(ws + WS_WBUF); bf16_t* MERGED = (bf16_t*)(ws + WS_ABUF); bf16_t* HBp = (bf16_t*)(ws + WS_WBUF);

#ifdef TIMING_A
    if (blockIdx.x == 0 && threadIdx.x < 4) ((volatile LAS unsigned long long*)(F.lds + LDS_BYTES - 256 + 128))[threadIdx.x] = 0ull;
#endif
    STAMP(0);
#ifdef ZERO_FILL
    {
        const size_t gt = (size_t)F.vcu * NTHREADS + F.tid, NGT = (size_t)F.G * NTHREADS;
        u32x4 z = {0u, 0u, 0u, 0u};
        u32x4* w4 = (u32x4*)ws; for (size_t i = gt; i < WS_END / 16; i += NGT) w4[i] = z;
        u32x4* o4 = (u32x4*)p.out; for (size_t i = gt; i < (size_t)NTOK * DM * 4 / 16; i += NGT) o4[i] = z;
    }
    GRID_BARRIER();
#endif
#if (PHM >> 0) & 1
    p0_prologue(F);
#endif
#ifdef P2_CHECK
    if (blockIdx.x == 0 && threadIdx.x == 0) *(unsigned*)(ws + 64) = 0u;
#endif
    GRID_BARRIER();
    STAMP(1);
#if (PHM >> 1) & 1
    {
        pg8::Gemm g{XN, WIN, NTOK, P1N, DM, DM, DM}; pg8::StaticOrder S; S.init(NTOK, P1N, F.G, (int)blockIdx.x);
        pg8::EpiStore<0> E{PROJ, nullptr, P1N, 0, (bf16_t*)(ws + WS_HALO), 1.0f};
        pg8::gemm_phase<pg8::EpiStore<0>, pg8::StaticOrder, true, true>(F.lds, g, S, E);
    }
#endif
    GRID_BARRIER();
    DUMP(1);
    STAMP(2);
#if (PHM >> 2) & 1
    p2h_pool(F);
    __syncthreads();
#endif
    DUMP(2);
    STAMP(3);
#if (PHM >> 3) & 1
    p2_chunk_prep(F, P2Out{(bf16_t*)(ws + WS_PROJ) + C_Q, (bf16_t*)(ws + WS_PROJ) + C_K, (bf16_t*)(ws + WS_PROJ) + C_V, P1N, (bf16_t*)(ws + WS_WBUF), (bf16_t*)(ws + WS_ABUF), (float*)(ws + WS_GC), 0, 0, NBATCH * NCHUNK * 8});
#endif
    GRID_BARRIER();
    DUMP(3);
    STAMP(4);
#if (PHM >> 4) & 1
    p3_scan(F);
#endif
    GRID_BARRIER();
    DUMP(4);
    STAMP(5);
#if (PHM >> 5) & 1
    p4_gated_norm(F);
#endif
#if (PHM >> 6) & 1
    {
        pg8::Gemm g{(const bf16_t*)(ws + WS_ABUF + 64 * MiB), WIN + (size_t)P1N * DM, NTOK, 2048, DM / 2, DM / 2, DM / 2}; pg8::StaticOrder S; S.init(NTOK, 2048, F.G, (int)blockIdx.x);
        pg8::EpiStore<1> E{GA, GB, DM, 1024, nullptr, 1.0f / (XN8_SCALE * WG8_SCALE)};
        pg8::gemm_phase<pg8::EpiStore<1>, pg8::StaticOrder, true, true, true>(F.lds, g, S, E);
    }
#endif
    GRID_BARRIER();
    DUMP(5);
    STAMP(6);
#if (PHM >> 7) & 1
    {
        pg8::Gemm g{(const bf16_t*)(ws + WS_POOLED), (const bf16_t*)(ws + WS_WPU), NTOK, DM, 512, 512, 512}; pg8::StaticOrder S; S.init(NTOK, DM, F.G, (int)blockIdx.x);
        pg8::EpiGateMul<false> E{MERGED, GA, DM, 1.0f};
        pg8::gemm_phase<pg8::EpiGateMul<false>, pg8::StaticOrder, true, true>(F.lds, g, S, E);
    }
#endif
    STAMP(7);
#if (PHM >> 8) & 1
    {
        pg8::Gemm g{(const bf16_t*)p.out, (const bf16_t*)(ws + WS_WDU), NTOK, DM, DM / 2, DM / 2, DM / 2}; pg8::StaticOrder S; S.init(NTOK, DM, F.G, (int)blockIdx.x);
        pg8::EpiGateMul<true> E{MERGED, GB, DM, 1.0f / (ON8_SCALE * WG8_SCALE)};
        pg8::gemm_phase<pg8::EpiGateMul<true>, pg8::StaticOrder, true, true, true>(F.lds, g, S, E);
    }
#endif
    GRID_BARRIER();
    DUMP(7);
    STAMP(8);
#if (PHM >> 9) & 1
    {
        pg8::Gemm g{MERGED, (const bf16_t*)(ws + WS_WMX), NTOK, DM, DM, DM, DM}; pg8::StaticOrder S; S.init(NTOK, DM, F.G, (int)blockIdx.x);
        pg8::EpiResid E{F.x, p.out, HBp, (float*)(ws + WS_SSQ), DM};
        pg8::gemm_phase<pg8::EpiResid, pg8::StaticOrder, true, true>(F.lds, g, S, E);
    }
#endif
    GRID_BARRIER();
    DUMP(8);
    STAMP(9);
#if (PHM >> 10) & 1
    {
        pg8::Gemm g{HBp, (const bf16_t*)(ws + WS_WQ), NTOK, 2048, DM, DM, DM}; pg8::StaticOrder S; S.init(NTOK, 2048, F.G, (int)blockIdx.x);
        pg8::EpiRowScale E{(bf16_t*)(ws + WS_Q2), (const float*)(ws + WS_SSQ), 2048, 1.0f / DM, EPS};
        pg8::gemm_phase<pg8::EpiRowScale, pg8::StaticOrder, true, true>(F.lds, g, S, E);
    }
#endif
    GRID_BARRIER();
    DUMP(9);
    STAMP(10);
#if (PHM >> 11) & 1
    p10_topk(F);
#endif
    GRID_BARRIER();
    DUMP(10);
    STAMP(11);
#if (PHM >> 12) & 1
    {
        F.sl_n = F.G / 8; F.sl_s = F.vcu / F.sl_n; F.sl_rk = F.vcu % F.sl_n;
#ifndef USE_CG
        bool even = true;
#pragma unroll
        for (int j = 0; j < 16; ++j) { const unsigned cnt = xb_ld((unsigned*)ws + XB_XCNT(j)); even = even && (cnt == ((j < 8) ? (unsigned)F.sl_n : 0u)); }
        const int tk = __builtin_amdgcn_readfirstlane(__shfl(xticket, 0));
        volatile LAS int* tkl = (volatile LAS int*)(F.lds + XB_ST_OFF + 64);
        if (threadIdx.x == 0) tkl[0] = tk;
        __syncthreads();
        const int tkb = tkl[0];
        if (even && (F.G % 8 == 0) && xbar.x < 8u && tkb < F.sl_n) { F.sl_s = (int)xbar.x; F.sl_rk = tkb; }
#endif
    }
#ifdef ABLATE_P11A
    { TACC_T0(); p11a_down<1>(F); GRID_BARRIER(); TACC_ADD(1); }
    { TACC_T0(); p11a_down<2>(F); GRID_BARRIER(); TACC_ADD(2); }
#endif
    { TACC_T0(); p11a_down<0>(F); GRID_BARRIER(); TACC_ADD(0); }
    { p11b_coef(F); GRID_BARRIER(); }
    { TACC_T0(); p11c_up(F); GRID_BARRIER(); TACC_ADD(3); }
    { p11d_final(F); }
#endif
#ifdef P2_CHECK
    GRID_BARRIER();
    if (blockIdx.x == 0 && threadIdx.x == 0) p.out[0] += 2.0f + 100000.0f * __uint_as_float(*(volatile unsigned*)(ws + 64));
#endif
#ifdef TIMING_A
    GRID_BARRIER();
    STAMP(12);
    if (blockIdx.x == 0) {
        asm volatile("s_waitcnt lgkmcnt(0)" ::: "memory"); __syncthreads();
        volatile LAS unsigned long long* ts = (volatile LAS unsigned long long*)(F.lds + TS_OFF);
        const float tot = (float)(ts[12] - ts[0]);
        volatile LAS unsigned long long* ta = (volatile LAS unsigned long long*)(F.lds + TS_OFF + 128);
        const float fa = (TIMING_A >= 100) ? (float)ta[TIMING_A - 100] / tot : (float)(ts[(TIMING_A % 100) + 1] - ts[TIMING_A % 100]) / tot;
        const float fb = (TIMING_B >= 100) ? (float)ta[TIMING_B - 100] / tot : (float)(ts[(TIMING_B % 100) + 1] - ts[TIMING_B % 100]) / tot;
        if (threadIdx.x == 0) p.out[0] += 2.0f + 100.0f * fa;
        const float db = sqrtf(fb);
        for (int k = 0; k < 128; ++k) p.out[1024 + threadIdx.x + 512 * k] += db;
    }
#endif
}

extern "C" void kernel_launch(void* const* d_in, const int* in_sizes, int n_in, void* d_out, int out_size, void* d_ws, size_t ws_size, hipStream_t stream) {
    static int grid = 0;
    if (grid == 0) {
        if (n_in != 19 || in_sizes[0] != NTOK * DM || out_size != NTOK * DM || ws_size < WS_END) {
            fprintf(stderr, "kernel_launch: unexpected shapes: n_in %d in0 %d out %d ws %zu (need %zu); nothing launched\n", n_in, n_in > 0 ? in_sizes[0] : -1, out_size, ws_size, (size_t)WS_END); grid = -1; return; }
        int dev = 0, cus = 0, per_cu = 0;
        (void)hipGetDevice(&dev); (void)hipDeviceGetAttribute(&cus, hipDeviceAttributeMultiprocessorCount, dev);
        (void)hipFuncSetAttribute((const void*)hybrid_fwd, hipFuncAttributeMaxDynamicSharedMemorySize, LDS_BYTES);
        (void)hipOccupancyMaxActiveBlocksPerMultiprocessor(&per_cu, (const void*)hybrid_fwd, NTHREADS, LDS_BYTES);
        if (per_cu < 1) { fprintf(stderr, "kernel_launch: occupancy query says %d blocks per CU\n", per_cu); per_cu = 1; }
        grid = cus;
    }
    if (grid < 0) return;
    Params p{};
    for (int i = 0; i < 19; ++i) p.in[i] = (const float*)d_in[i];
    p.out = (float*)d_out; p.ws = (unsigned char*)d_ws;
#ifdef USE_CG
    void* args[] = {&p};
    hipError_t e = hipLaunchCooperativeKernel((const void*)hybrid_fwd, dim3(grid), dim3(NTHREADS), args, LDS_BYTES, stream);
    if (e != hipSuccess) fprintf(stderr, "cooperative launch failed: %s (grid %d)\n", hipGetErrorString(e), grid);
#else
    if (hipMemsetAsync(d_ws, 0, 32768, stream) != hipSuccess) { fprintf(stderr, "kernel_launch: hipMemsetAsync failed\n"); return; }
    hipLaunchKernelGGL(hybrid_fwd, dim3(grid), dim3(NTHREADS), LDS_BYTES, stream, p);
    const hipError_t e = hipPeekAtLastError();
    if (e != hipSuccess) fprintf(stderr, "launch failed: %s (grid %d)\n", hipGetErrorName(e), grid);
#endif
}
```
